# Optimizing an MI355X kernel written in HIP

```python
import jax
import jax.numpy as jnp
from jax import lax
import numpy as np

D_MODEL = 1024
BATCH = 16
SEQ = 2048
DEPTH = 1

EPS = 1e-6
HEAD_DIM = 64
ROPE_THETA = 10000.0

NSA_HEADS = 8
NSA_KV_GROUPS = 2
NSA_GROUP = NSA_HEADS // NSA_KV_GROUPS
NSA_WIDTH = NSA_HEADS * HEAD_DIM
KV_WIDTH = NSA_KV_GROUPS * HEAD_DIM
CMP_BLOCK = 32
CMP_STRIDE = 16
CMP_HIDDEN = 128
SEL_BLOCK = 64
SEL_TOPK = 16
WINDOW = 512
Q_CHUNK = 32
FORCE_BONUS = 1000.0

HGRN_HEADS = 4
HGRN_EXPAND = 128
HGRN_HEAD_V = 128
HGRN_WIDTH = HGRN_HEADS * HGRN_EXPAND
HGRN_V_WIDTH = HGRN_HEADS * HGRN_HEAD_V
HGRN_CHUNK = 32

PEER_HEADS = 8
PEER_NKEYS = 128
PEER_NEXPERTS = PEER_NKEYS * PEER_NKEYS
PEER_QDIM = 256
PEER_TOPK = 16
PEER_TOK_CHUNK = 128

IN_SPLITS = (NSA_WIDTH, KV_WIDTH, KV_WIDTH, KV_WIDTH, KV_WIDTH, KV_WIDTH, KV_WIDTH, 3 * NSA_HEADS, HGRN_WIDTH, HGRN_WIDTH, HGRN_V_WIDTH, HGRN_V_WIDTH, 2 * D_MODEL)
IN_COLS = NSA_WIDTH + 6 * KV_WIDTH + 3 * NSA_HEADS + 2 * HGRN_WIDTH + 2 * HGRN_V_WIDTH + 2 * D_MODEL

kernel_name = 'nsa_hgrn2_peer_hybrid_block'


def _rmsnorm(x, g):
    xf = x.astype(jnp.float32)
    y = xf * lax.rsqrt(jnp.mean(xf * xf, axis=-1, keepdims=True) + EPS)
    return (y * g.astype(jnp.float32)).astype(x.dtype)


def _masked_softmax(s, mask):
    s = jnp.where(mask, s.astype(jnp.float32), -jnp.inf)
    m = jnp.max(s, axis=-1, keepdims=True)
    m = jnp.where(jnp.isfinite(m), m, 0.0)
    p = jnp.exp(s - m)
    return p / jnp.maximum(jnp.sum(p, axis=-1, keepdims=True), 1e-30)


def _rope(x, pos):
    half = HEAD_DIM // 2
    inv = ROPE_THETA ** (-jnp.arange(half, dtype=jnp.float32) / half)
    ang = pos.astype(jnp.float32)[:, None] * inv[None, :]
    cos = jnp.cos(ang)[None, :, None, :]
    sin = jnp.sin(ang)[None, :, None, :]
    xf = x.astype(jnp.float32)
    x1, x2 = xf[..., :half], xf[..., half:]
    return jnp.concatenate([x1 * cos - x2 * sin, x2 * cos + x1 * sin], axis=-1).astype(x.dtype)


def _selection_map(n_cmp, n_sel):
    r_sel = SEL_BLOCK // CMP_STRIDE
    r_cmp = CMP_BLOCK // CMP_STRIDE
    i = np.arange(n_cmp)[:, None]
    j = np.arange(n_sel)[None, :]
    d = i - r_sel * j
    cnt = np.minimum(d, r_sel - 1) - np.maximum(d - r_cmp + 1, 0) + 1
    return np.clip(cnt, 0, None).astype(np.float32)


def _compress(k, pos_emb, w1, w2):
    B, T = k.shape[0], k.shape[1]
    r = CMP_BLOCK // CMP_STRIDE
    pieces = k.reshape(B, T // CMP_STRIDE, CMP_STRIDE, NSA_KV_GROUPS, HEAD_DIM)
    n_cmp = T // CMP_STRIDE - r + 1
    blocks = jnp.concatenate([pieces[:, j:j + n_cmp] for j in range(r)], axis=2)
    blocks = blocks + pos_emb[None, None, :, None, :]
    flat = blocks.transpose(0, 1, 3, 2, 4).reshape(B, n_cmp, NSA_KV_GROUPS, CMP_BLOCK * HEAD_DIM)
    return jax.nn.gelu(flat @ w1) @ w2


def _nsa(q, k_c, v_c, k_s, v_s, k_w, v_w, gate_logits, cmp_pos_k, cmp_pos_v, w_ck1, w_ck2, w_cv1, w_cv2):
    B, T = q.shape[0], q.shape[1]
    G, R, dh = NSA_KV_GROUPS, NSA_GROUP, HEAD_DIM
    scale = HEAD_DIM ** -0.5
    kc = _compress(k_c, cmp_pos_k, w_ck1, w_ck2)
    vc = _compress(v_c, cmp_pos_v, w_cv1, w_cv2)
    n_cmp = kc.shape[1]
    cmp_end = jnp.arange(n_cmp) * CMP_STRIDE + CMP_BLOCK - 1
    n_sel = T // SEL_BLOCK
    top_n = min(SEL_TOPK, n_sel)
    sel_map = jnp.asarray(_selection_map(n_cmp, n_sel))
    ks_blocks = k_s.reshape(B, n_sel, SEL_BLOCK, G, dh).transpose(0, 3, 1, 2, 4)
    vs_blocks = v_s.reshape(B, n_sel, SEL_BLOCK, G, dh).transpose(0, 3, 1, 2, 4)
    kw_pad = jnp.pad(k_w, ((0, 0), (WINDOW, 0), (0, 0), (0, 0)))
    vw_pad = jnp.pad(v_w, ((0, 0), (WINDOW, 0), (0, 0), (0, 0)))
    n_chunks = T // Q_CHUNK
    q_chunks = q.reshape(B, n_chunks, Q_CHUNK, G, R, dh).transpose(1, 0, 2, 3, 4, 5)
    g_chunks = gate_logits.reshape(B, n_chunks, Q_CHUNK, G, R, 3).transpose(1, 0, 2, 3, 4, 5)
    b_ix = jnp.arange(B)[:, None, None, None]
    g_ix = jnp.arange(G)[None, None, :, None]
    blk_ids = jnp.arange(n_sel)
    in_blk = jnp.arange(SEL_BLOCK)
    win_off = jnp.arange(WINDOW + Q_CHUNK)

    def chunk_fn(args):
        ci, qg, gl = args
        start = ci * Q_CHUNK
        t = start + jnp.arange(Q_CHUNK)
        s_c = jnp.einsum('bqgrd,bngd->bqgrn', qg, kc) * scale
        m_c = (cmp_end[None, :] <= t[:, None])[None, :, None, None, :]
        p_c = _masked_softmax(s_c, m_c)
        o_c = jnp.einsum('bqgrn,bngd->bqgrd', p_c.astype(vc.dtype), vc)
        imp = jnp.einsum('bqgrn,nj->bqgj', p_c, sel_map)
        cur = t // SEL_BLOCK
        forced = (blk_ids[None, :] == 0) | (blk_ids[None, :] == cur[:, None]) | (blk_ids[None, :] == cur[:, None] - 1)
        causal_blk = blk_ids[None, :] * SEL_BLOCK <= t[:, None]
        imp = jnp.where(forced[None, :, None, :], imp + FORCE_BONUS, imp)
        imp = jnp.where(causal_blk[None, :, None, :], imp, -1.0)
        _, idx = lax.top_k(imp, top_n)
        kg = ks_blocks[b_ix, g_ix, idx]
        vg = vs_blocks[b_ix, g_ix, idx]
        s_s = jnp.einsum('bqgrd,bqgnld->bqgrnl', qg, kg) * scale
        kpos = idx[..., None] * SEL_BLOCK + in_blk
        m_s = (kpos <= t[None, :, None, None, None]).reshape(B, Q_CHUNK, G, 1, top_n * SEL_BLOCK)
        p_s = _masked_softmax(s_s.reshape(B, Q_CHUNK, G, R, top_n * SEL_BLOCK), m_s)
        p_s = p_s.reshape(B, Q_CHUNK, G, R, top_n, SEL_BLOCK).astype(vg.dtype)
        o_s = jnp.einsum('bqgrnl,bqgnld->bqgrd', p_s, vg)
        kw_c = lax.dynamic_slice_in_dim(kw_pad, start, WINDOW + Q_CHUNK, axis=1)
        vw_c = lax.dynamic_slice_in_dim(vw_pad, start, WINDOW + Q_CHUNK, axis=1)
        kpos_w = start - WINDOW + win_off
        m_w = (kpos_w[None, :] <= t[:, None]) & (t[:, None] - kpos_w[None, :] < WINDOW) & (kpos_w[None, :] >= 0)
        s_w = jnp.einsum('bqgrd,bkgd->bqgrk', qg, kw_c) * scale
        p_w = _masked_softmax(s_w, m_w[None, :, None, None, :])
        o_w = jnp.einsum('bqgrk,bkgd->bqgrd', p_w.astype(vw_c.dtype), vw_c)
        g = jax.nn.sigmoid(gl.astype(jnp.float32)).astype(qg.dtype)
        o = g[..., 0:1] * o_c + g[..., 1:2] * o_s + g[..., 2:3] * o_w
        return o.reshape(B, Q_CHUNK, NSA_WIDTH)

    out = lax.map(chunk_fn, (jnp.arange(n_chunks), q_chunks, g_chunks))
    return out.transpose(1, 0, 2, 3).reshape(B, T, NSA_WIDTH)


def _hgrn2(hq, hf, hi, hg, lb, norm_g):
    B, T = hq.shape[0], hq.shape[1]
    H, dk, dv, C = HGRN_HEADS, HGRN_EXPAND, HGRN_HEAD_V, HGRN_CHUNK
    f = lb + (1.0 - lb) * jax.nn.sigmoid(hf.astype(jnp.float32))
    log_f = jnp.log(f)
    k = 1.0 - f
    q = jax.nn.silu(hq.astype(jnp.float32))
    v = hi.astype(jnp.float32)
    nc = T // C

    def to_chunks(a, d):
        return a.reshape(B, nc, C, H, d).transpose(1, 0, 3, 2, 4)

    causal = jnp.tril(jnp.ones((C, C), dtype=bool))

    def step(S, xs):
        qc, kc, vc, lfc = xs
        b = jnp.cumsum(lfc, axis=2)
        b_end = b[:, :, -1:, :]
        q_dec = qc * jnp.exp(b)
        k_inv = kc * jnp.exp(-b)
        k_end = kc * jnp.exp(b_end - b)
        A = jnp.where(causal, jnp.einsum('bhtd,bhsd->bhts', q_dec, k_inv), 0.0)
        o = jnp.einsum('bhts,bhse->bhte', A, vc) + jnp.einsum('bhtd,bhde->bhte', q_dec, S)
        S = jnp.exp(b_end)[:, :, 0, :, None] * S + jnp.einsum('bhsd,bhse->bhde', k_end, vc)
        return S, o

    S0 = jnp.zeros((B, H, dk, dv), jnp.float32)
    _, o = lax.scan(step, S0, (to_chunks(q, dk), to_chunks(k, dk), to_chunks(v, dv), to_chunks(log_f, dk)))
    o = o.transpose(1, 0, 3, 2, 4).reshape(B, T, H, dv).astype(hq.dtype)
    o = _rmsnorm(o, norm_g) * jax.nn.silu(hg.reshape(B, T, H, dv))
    return o.reshape(B, T, HGRN_V_WIDTH)


def _hybrid_mixer(h, layer_lb, w_in, cmp_pos_k, cmp_pos_v, w_ck1, w_ck2, w_cv1, w_cv2, norm_g, w_branch, w_out):
    B, T = h.shape[0], h.shape[1]
    proj = h @ w_in
    cuts = np.cumsum(IN_SPLITS)[:-1].tolist()
    q, k_c, v_c, k_s, v_s, k_w, v_w, nsa_gl, hq, hf, hi, hg, merge = jnp.split(proj, cuts, axis=-1)
    pos = jnp.arange(T)

    def heads(a, n):
        return a.reshape(B, T, n, HEAD_DIM)

    q = _rope(heads(q, NSA_HEADS), pos)
    k_c = _rope(heads(k_c, NSA_KV_GROUPS), pos)
    k_s = _rope(heads(k_s, NSA_KV_GROUPS), pos)
    k_w = _rope(heads(k_w, NSA_KV_GROUPS), pos)
    o_nsa = _nsa(q, k_c, heads(v_c, NSA_KV_GROUPS), k_s, heads(v_s, NSA_KV_GROUPS), k_w, heads(v_w, NSA_KV_GROUPS), nsa_gl.reshape(B, T, NSA_HEADS, 3), cmp_pos_k, cmp_pos_v, w_ck1, w_ck2, w_cv1, w_cv2)
    o_hgrn = _hgrn2(hq, hf, hi, hg, layer_lb, norm_g)
    g_a, g_b = jnp.split(jax.nn.sigmoid(merge.astype(jnp.float32)).astype(h.dtype), 2, axis=-1)
    y = g_a * (o_nsa @ w_branch[0]) + g_b * (o_hgrn @ w_branch[1])
    return y @ w_out


def _peer(h, w_q, sub_keys, u_tab, v_tab):
    B, T, D = h.shape
    n = B * T
    K = PEER_TOPK
    xt = h.reshape(n, D)
    q = (xt @ w_q).reshape(n, PEER_HEADS, 2, PEER_QDIM // 2)
    s = jnp.einsum('nhpd,phkd->nhpk', q, sub_keys).astype(jnp.float32)
    s1, i1 = lax.top_k(s[:, :, 0], K)
    s2, i2 = lax.top_k(s[:, :, 1], K)
    comb = (s1[..., :, None] + s2[..., None, :]).reshape(n, PEER_HEADS, K * K)
    cand = (i1[..., :, None] * PEER_NKEYS + i2[..., None, :]).reshape(n, PEER_HEADS, K * K)
    top_s, pos = lax.top_k(comb, K)
    experts = jnp.take_along_axis(cand, pos, axis=-1)
    gate = jax.nn.softmax(top_s, axis=-1).astype(h.dtype)
    n_chunks = n // PEER_TOK_CHUNK

    def chunk_fn(args):
        xc, ec, gc = args
        a = jax.nn.gelu(jnp.einsum('nd,nhkd->nhk', xc, u_tab[ec]))
        return jnp.einsum('nhk,nhkd->nd', gc * a, v_tab[ec])

    y = lax.map(chunk_fn, (xt.reshape(n_chunks, PEER_TOK_CHUNK, D), experts.reshape(n_chunks, PEER_TOK_CHUNK, PEER_HEADS, K), gate.reshape(n_chunks, PEER_TOK_CHUNK, PEER_HEADS, K)))
    return y.reshape(B, T, D)


def setup_inputs(seed: int = 0) -> dict:
    key = jax.random.key(seed)
    ks = jax.random.split(key, 22)

    def nrm(k, shape, s):
        return jax.random.normal(k, shape, jnp.float32) * s

    D = D_MODEL
    return {
        'x': nrm(ks[0], (BATCH, SEQ, D), 1.0),
        'c': nrm(ks[1], (BATCH, D), 1.0),
        'w_ada': nrm(ks[2], (DEPTH, D, 6 * D), 0.02),
        'b_ada': nrm(ks[3], (DEPTH, 6 * D), 0.02),
        'g_mix': 1.0 + nrm(ks[4], (DEPTH, D), 0.02),
        'g_ffn': 1.0 + nrm(ks[5], (DEPTH, D), 0.02),
        'w_in': nrm(ks[6], (DEPTH, D, IN_COLS), D ** -0.5),
        'cmp_pos_k': nrm(ks[7], (DEPTH, CMP_BLOCK, HEAD_DIM), 0.02),
        'cmp_pos_v': nrm(ks[8], (DEPTH, CMP_BLOCK, HEAD_DIM), 0.02),
        'w_ck1': nrm(ks[9], (DEPTH, CMP_BLOCK * HEAD_DIM, CMP_HIDDEN), (CMP_BLOCK * HEAD_DIM) ** -0.5),
        'w_ck2': nrm(ks[10], (DEPTH, CMP_HIDDEN, HEAD_DIM), CMP_HIDDEN ** -0.5),
        'w_cv1': nrm(ks[11], (DEPTH, CMP_BLOCK * HEAD_DIM, CMP_HIDDEN), (CMP_BLOCK * HEAD_DIM) ** -0.5),
        'w_cv2': nrm(ks[12], (DEPTH, CMP_HIDDEN, HEAD_DIM), CMP_HIDDEN ** -0.5),
        'hgrn_lb_logits': nrm(ks[13], (DEPTH + 1, HGRN_WIDTH), 0.5),
        'hgrn_out_norm': 1.0 + nrm(ks[14], (DEPTH, HGRN_HEAD_V), 0.02),
        'w_branch': nrm(ks[15], (DEPTH, 2, NSA_WIDTH, D), NSA_WIDTH ** -0.5),
        'w_out': nrm(ks[16], (DEPTH, D, D), D ** -0.5),
        'w_peer_q': nrm(ks[17], (DEPTH, D, PEER_HEADS * PEER_QDIM), D ** -0.5),
        'peer_sub_keys': nrm(ks[18], (DEPTH, 2, PEER_HEADS, PEER_NKEYS, PEER_QDIM // 2), (PEER_QDIM // 2) ** -0.5),
        'peer_u': nrm(ks[19], (DEPTH, PEER_NEXPERTS, D), D ** -0.5),
        'peer_v': nrm(ks[20], (DEPTH, PEER_NEXPERTS, D), 0.5),
        'g_final': 1.0 + nrm(ks[21], (D,), 0.02),
    }


def reference(x, c, w_ada, b_ada, g_mix, g_ffn, w_in, cmp_pos_k, cmp_pos_v, w_ck1, w_ck2, w_cv1, w_cv2, hgrn_lb_logits, hgrn_out_norm, w_branch, w_out, w_peer_q, peer_sub_keys, peer_u, peer_v, g_final):
    lb_all = jnp.cumsum(jax.nn.softmax(hgrn_lb_logits.astype(jnp.float32), axis=0), axis=0)
    cs = jax.nn.silu(c)
    for l in range(DEPTH):
        mod = cs @ w_ada[l] + b_ada[l]
        sh_m, sc_m, gt_m, sh_f, sc_f, gt_f = [m[:, None, :] for m in jnp.split(mod, 6, axis=-1)]
        h = _rmsnorm(x, g_mix[l]) * (1.0 + sc_m) + sh_m
        y = _hybrid_mixer(h, lb_all[l], w_in[l], cmp_pos_k[l], cmp_pos_v[l], w_ck1[l], w_ck2[l], w_cv1[l], w_cv2[l], hgrn_out_norm[l], w_branch[l], w_out[l])
        x = x + gt_m * y
        h = _rmsnorm(x, g_ffn[l]) * (1.0 + sc_f) + sh_f
        x = x + gt_f * _peer(h, w_peer_q[l], peer_sub_keys[l], peer_u[l], peer_v[l])
    return _rmsnorm(x, g_final)
```

```cpp
#include <hip/hip_runtime.h>
#include <hip/hip_bf16.h>
#include <cstdio>
#include <cstdint>

typedef unsigned short bf16_t;
#define LAS __attribute__((address_space(3)))

constexpr int DM = 1024, NB = 16, SEQ = 2048, NTOK = NB * SEQ;
constexpr int IN_COLS = 5400, NPROJ = 5632;
constexpr size_t MiB = 1ull << 20;
constexpr size_t WS_WIN = 0;
constexpr size_t WS_WB = 11 * MiB;
constexpr size_t WS_WOUT = 13 * MiB;
constexpr size_t WS_WQ = 15 * MiB;
constexpr size_t WS_U = 19 * MiB;
constexpr size_t WS_V = 51 * MiB;
constexpr size_t WS_SMALL = 83 * MiB;
constexpr size_t WS_MOD = WS_SMALL;
constexpr size_t WS_ROPEC = WS_MOD + 16 * 6144 * 4;
constexpr size_t WS_ROPES = WS_ROPEC + 2048 * 32 * 4;
constexpr size_t WS_LB = WS_ROPES + 2048 * 32 * 4;
constexpr size_t WS_KCMP = WS_LB + 512 * 4;
constexpr size_t WS_VCMP = WS_KCMP + 16 * 127 * 2 * 64 * 4;
constexpr size_t WS_HBF = 88 * MiB;
constexpr size_t WS_ONSA = WS_HBF;
constexpr size_t WS_OHGRN = WS_HBF + 32 * MiB;
constexpr size_t WS_PA = 152 * MiB;
constexpr size_t WS_PH = 232 * MiB;
constexpr size_t WS_PM = 360 * MiB;
constexpr size_t WS_PG = 488 * MiB;
constexpr size_t WS_YA = 152 * MiB;
constexpr size_t WS_Y = 280 * MiB;
constexpr size_t WS_Q = 152 * MiB;
constexpr size_t WS_END = 504 * MiB;

struct Params {
    const float* x; const float* c; const float* w_ada; const float* b_ada; const float* g_mix; const float* g_ffn; const float* w_in;
    const float* cmp_pos_k; const float* cmp_pos_v; const float* w_ck1; const float* w_ck2; const float* w_cv1; const float* w_cv2;
    const float* lb_logits; const float* out_norm; const float* w_branch; const float* w_out; const float* w_peer_q; const float* sub_keys;
    const float* peer_u; const float* peer_v; const float* g_final;
    float* out; unsigned char* ws;
};

__device__ __forceinline__ float bf2f(bf16_t v) { return __uint_as_float((unsigned)v << 16); }
__device__ __forceinline__ bf16_t f2bf(float f) { unsigned u = __float_as_uint(f); u += 0x7fffu + ((u >> 16) & 1u); return (bf16_t)(u >> 16); }
__device__ __forceinline__ unsigned pack2bf(float lo, float hi) { return (unsigned)f2bf(lo) | ((unsigned)f2bf(hi) << 16); }
__device__ __forceinline__ float wave_sum(float v) { for (int o = 32; o >= 1; o >>= 1) v += __shfl_xor(v, o); return v; }
__device__ __forceinline__ float wave_max(float v) { for (int o = 32; o >= 1; o >>= 1) v = fmaxf(v, __shfl_xor(v, o)); return v; }
__device__ __forceinline__ float sigmoidf_(float x) { return 1.0f / (1.0f + __expf(-x)); }
__device__ __forceinline__ float gelu_tanh(float x) { const float u = 0.7978845608028654f * (x + 0.044715f * x * x * x); return 0.5f * x * (1.0f + tanhf(u)); }
__device__ __forceinline__ void wave_lds_sync() { asm volatile("s_waitcnt lgkmcnt(0)" ::: "memory"); }

namespace pg8 {
typedef short bf16x8 __attribute__((ext_vector_type(8)));
typedef float f32x4 __attribute__((ext_vector_type(4)));
typedef unsigned u32x4 __attribute__((ext_vector_type(4)));
typedef unsigned u32x2 __attribute__((ext_vector_type(2)));
constexpr int BM = 256, BK = 64, HALF = 128, HTB = HALF * BK * 2, STAGE_BYTES = 8 * HTB, NXCD = 8, WGM = 8;
__host__ __device__ __forceinline__ int lds_byte(int r, int c) { const int st = (r >> 4) * 2 + (c >> 5), rr = r & 15, cc = c & 31, ob = rr * 64 + cc * 2; return st * 1024 + (ob ^ (((ob >> 9) & 1) << 5)); }
__host__ __device__ __forceinline__ void stage_rc(int b, int& R, int& C) { const int st = b / 1024, sb = b % 1024, swz = sb ^ (((sb >> 9) & 1) << 5); R = (st >> 1) * 16 + swz / 64; C = (st & 1) * 32 + (swz % 64) / 2; }
__host__ __device__ __forceinline__ int perm32(int rho) { const int n = rho >> 4, i = rho & 15; return 8 * (i >> 2) + 4 * n + (i & 3); }
struct Unit { int pm, pn; };
struct Gemm { const bf16_t* A; const bf16_t* Bt; int M, N, K, pad_; };
struct StaticOrder {
    int nM, nN, nwg, G, c;
    __host__ __device__ void init(int M, int N, int G_, int c_) { nM = M / BM; nN = N / BM; nwg = nM * nN; G = G_; c = c_; }
    __host__ __device__ bool next(int i, Unit& u) const {
        const long L = (long)i * G + c; if (L >= nwg) return false;
        int wgid = (int)L; { const int q = nwg / NXCD, r = nwg % NXCD, xcd = wgid % NXCD, off = wgid / NXCD; wgid = (xcd < r ? xcd * (q + 1) : r * (q + 1) + (xcd - r) * q) + off; }
        const int nig = WGM * nN, gid = wgid / nig, fm = gid * WGM, gsz = (nM - fm) < WGM ? (nM - fm) : WGM;
        u.pm = fm + ((wgid % nig) % gsz); u.pn = (wgid % nig) / gsz; return true;
    }
    __device__ __forceinline__ void a_ready(const Unit&) const {}
    __device__ __forceinline__ void done(const Unit&) const {}
};
__device__ __forceinline__ unsigned cvt_pk_bf16(float lo, float hi) { unsigned r; asm volatile("v_cvt_pk_bf16_f32 %0, %1, %2" : "=v"(r) : "v"(lo), "v"(hi)); return r; }

struct EpiF32 {
    static constexpr bool PERM = false, AFTER_DRAIN = false;
    float* C; int ldc; int pad_;
    __device__ __forceinline__ void operator()(const f32x4 (&acc)[2][2][4][2], const Unit& u, int wr, int wc, int fr, int fq) const {
        const int row0 = u.pm * BM + wr * 64 + fr, col0 = u.pn * BM + wc * 32 + 4 * fq;
#pragma unroll
        for (int ai = 0; ai < 2; ++ai)
#pragma unroll
            for (int m = 0; m < 4; ++m) { float* rowp = C + (size_t)(row0 + ai * HALF + m * 16) * ldc + col0;
#pragma unroll
                for (int bj = 0; bj < 2; ++bj)
#pragma unroll
                    for (int n = 0; n < 2; ++n) *(f32x4*)(rowp + bj * HALF + n * 16) = acc[ai][bj][m][n]; }
    }
};
struct EpiProj {
    static constexpr bool PERM = true, AFTER_DRAIN = false;
    bf16_t* PA; bf16_t* PH; bf16_t* PM; bf16_t* PG;
    __device__ __forceinline__ void operator()(const f32x4 (&acc)[2][2][4][2], const Unit& u, int wr, int wc, int fr, int fq) const {
        const int row0 = u.pm * BM + wr * 64 + fr;
        bf16_t* base; int ldc, colt;
        if (u.pn < 5) { base = PA; ldc = 1280; colt = u.pn * 256; }
        else if (u.pn < 13) { base = PH; ldc = 2048; colt = (u.pn - 5) * 256; }
        else if (u.pn < 21) { base = PM; ldc = 2048; colt = (u.pn - 13) * 256; }
        else { base = PG; ldc = 256; colt = 0; }
        const int col0 = colt + wc * 32 + 8 * fq;
#pragma unroll
        for (int ai = 0; ai < 2; ++ai)
#pragma unroll
            for (int m = 0; m < 4; ++m) { bf16_t* rowp = base + (size_t)(row0 + ai * HALF + m * 16) * ldc + col0;
#pragma unroll
                for (int bj = 0; bj < 2; ++bj) { const f32x4 v0 = acc[ai][bj][m][0], v1 = acc[ai][bj][m][1];
                    u32x4 w; w.x = cvt_pk_bf16(v0[0], v0[1]); w.y = cvt_pk_bf16(v0[2], v0[3]); w.z = cvt_pk_bf16(v1[0], v1[1]); w.w = cvt_pk_bf16(v1[2], v1[3]);
                    *(u32x4*)(rowp + bj * HALF) = w; } }
    }
};
struct EpiGateA {
    static constexpr bool PERM = false, AFTER_DRAIN = false;
    float* YA; const bf16_t* PM;
    __device__ __forceinline__ void operator()(const f32x4 (&acc)[2][2][4][2], const Unit& u, int wr, int wc, int fr, int fq) const {
        const int row0 = u.pm * BM + wr * 64 + fr, col0 = u.pn * BM + wc * 32 + 4 * fq;
#pragma unroll
        for (int ai = 0; ai < 2; ++ai)
#pragma unroll
            for (int m = 0; m < 4; ++m) { const size_t row = (size_t)(row0 + ai * HALF + m * 16);
#pragma unroll
                for (int bj = 0; bj < 2; ++bj)
#pragma unroll
                    for (int n = 0; n < 2; ++n) { const int col = col0 + bj * HALF + n * 16;
                        const u32x2 g = *(const u32x2*)(PM + row * 2048 + col);
                        f32x4 a = acc[ai][bj][m][n];
                        a[0] *= sigmoidf_(__uint_as_float(g.x << 16)); a[1] *= sigmoidf_(__uint_as_float(g.x & 0xffff0000u));
                        a[2] *= sigmoidf_(__uint_as_float(g.y << 16)); a[3] *= sigmoidf_(__uint_as_float(g.y & 0xffff0000u));
                        *(f32x4*)(YA + row * 1024 + col) = a; } }
    }
};
struct EpiGateB {
    static constexpr bool PERM = false, AFTER_DRAIN = false;
    const float* YA; const bf16_t* PM; bf16_t* Y;
    __device__ __forceinline__ void operator()(const f32x4 (&acc)[2][2][4][2], const Unit& u, int wr, int wc, int fr, int fq) const {
        const int row0 = u.pm * BM + wr * 64 + fr, col0 = u.pn * BM + wc * 32 + 4 * fq;
#pragma unroll
        for (int ai = 0; ai < 2; ++ai)
#pragma unroll
            for (int m = 0; m < 4; ++m) { const size_t row = (size_t)(row0 + ai * HALF + m * 16);
#pragma unroll
                for (int bj = 0; bj < 2; ++bj)
#pragma unroll
                    for (int n = 0; n < 2; ++n) { const int col = col0 + bj * HALF + n * 16;
                        const u32x2 g = *(const u32x2*)(PM + row * 2048 + 1024 + col);
                        const f32x4 ya = *(const f32x4*)(YA + row * 1024 + col);
                        f32x4 a = acc[ai][bj][m][n];
                        a[0] = ya[0] + a[0] * sigmoidf_(__uint_as_float(g.x << 16)); a[1] = ya[1] + a[1] * sigmoidf_(__uint_as_float(g.x & 0xffff0000u));
                        a[2] = ya[2] + a[2] * sigmoidf_(__uint_as_float(g.y << 16)); a[3] = ya[3] + a[3] * sigmoidf_(__uint_as_float(g.y & 0xffff0000u));
                        u32x2 w; w.x = cvt_pk_bf16(a[0], a[1]); w.y = cvt_pk_bf16(a[2], a[3]);
                        *(u32x2*)(Y + row * 1024 + col) = w; } }
    }
};
struct EpiResid {
    static constexpr bool PERM = false, AFTER_DRAIN = false;
    const float* X; const float* mod; float* X1;
    __device__ __forceinline__ void operator()(const f32x4 (&acc)[2][2][4][2], const Unit& u, int wr, int wc, int fr, int fq) const {
        const int row0 = u.pm * BM + wr * 64 + fr, col0 = u.pn * BM + wc * 32 + 4 * fq;
        const int b = (u.pm * BM) >> 11;
#pragma unroll
        for (int ai = 0; ai < 2; ++ai)
#pragma unroll
            for (int m = 0; m < 4; ++m) { const size_t row = (size_t)(row0 + ai * HALF + m * 16);
#pragma unroll
                for (int bj = 0; bj < 2; ++bj)
#pragma unroll
                    for (int n = 0; n < 2; ++n) { const int col = col0 + bj * HALF + n * 16;
                        const f32x4 gt = *(const f32x4*)(mod + b * 6144 + 2048 + col);
                        const f32x4 xv = *(const f32x4*)(X + row * 1024 + col);
                        *(f32x4*)(X1 + row * 1024 + col) = xv + gt * acc[ai][bj][m][n]; } }
    }
};

template <class Epi, class Sched>
__device__ __forceinline__ void gemm_phase(LAS unsigned char* lds, const Gemm g, const Sched& S, const Epi& E) {
    const int tid = threadIdx.x, wid = __builtin_amdgcn_readfirstlane(tid >> 6), lane = tid & 63, wr = wid >> 2, wc = wid & 3, fr = lane & 15, fq = lane >> 4;
    const int K = g.K, nt = K / BK;
    unsigned voffA[2], voffB[2];
#pragma unroll
    for (int i = 0; i < 2; ++i) { int R, C; stage_rc(tid * 16 + i * 8192, R, C); const int Rb = Epi::PERM ? ((R & ~31) + perm32(R & 31)) : R;
        voffA[i] = (unsigned)(R * K + C) * 2u; voffB[i] = (unsigned)(Rb * K + C) * 2u; }
    const size_t kstep = (size_t)(BK * 2);
    const size_t hstep = (size_t)HALF * K * 2;
    const size_t tstep = 2 * hstep;
    const unsigned ldsw = (unsigned)wid * 1024u;
    const int aoff = lds_byte(wr * 64 + fr, fq * 8), boff = lds_byte(wc * 32 + fr, fq * 8);
#define PG8_SA(b, h) (((b) * 2 + (h)) * HTB)
#define PG8_SB(b, h) ((4 + (b) * 2 + (h)) * HTB)
#define PG8_STAGE(bufoff, gbase, voff) do { _Pragma("unroll") for (int _i = 0; _i < 2; ++_i) \
        __builtin_amdgcn_global_load_lds((const unsigned*)((const char*)(gbase) + (voff)[_i]), (LAS unsigned*)(lds + (bufoff) + ldsw + _i * 8192), 16, 0, 0); } while (0)
#define PG8_LDA(dst, b, h) do { _Pragma("unroll") for (int m = 0; m < 4; ++m) _Pragma("unroll") for (int k = 0; k < 2; ++k) dst[m][k] = *(const LAS bf16x8*)(lds + PG8_SA(b, h) + aoff + m * 2048 + k * 1024); } while (0)
#define PG8_LDB(dst, b, h) do { _Pragma("unroll") for (int n = 0; n < 2; ++n) _Pragma("unroll") for (int k = 0; k < 2; ++k) dst[n][k] = *(const LAS bf16x8*)(lds + PG8_SB(b, h) + boff + n * 2048 + k * 1024); } while (0)
#define PG8_MMA(ai, bj, At, Bt) do { __builtin_amdgcn_s_setprio(1); _Pragma("unroll") for (int m = 0; m < 4; ++m) _Pragma("unroll") for (int n = 0; n < 2; ++n) _Pragma("unroll") for (int k = 0; k < 2; ++k) \
        acc[ai][bj][m][n] = __builtin_amdgcn_mfma_f32_16x16x32_bf16(Bt[n][k], At[m][k], acc[ai][bj][m][n], 0, 0, 0); __builtin_amdgcn_s_setprio(0); } while (0)
#define PG8_WAIT_V(n) asm volatile("s_waitcnt vmcnt(" #n ")" ::: "memory")
#define PG8_WAIT_L(n) asm volatile("s_waitcnt lgkmcnt(" #n ")" ::: "memory")
#define PG8_BAR __builtin_amdgcn_s_barrier()
#define PG8_SCHED __builtin_amdgcn_sched_barrier(0)
    Unit cur, nxt; int ui = 0;
    if (!S.next(0, cur)) return;
    f32x4 acc[2][2][4][2];
#pragma unroll
    for (int a = 0; a < 2; ++a)
#pragma unroll
        for (int b = 0; b < 2; ++b)
#pragma unroll
            for (int m = 0; m < 4; ++m)
#pragma unroll
                for (int n = 0; n < 2; ++n) acc[a][b][m][n] = (f32x4){0.f, 0.f, 0.f, 0.f};
    bf16x8 At[4][2], B0[2][2], B1[2][2];
    const char* cA = (const char*)g.A + (size_t)cur.pm * tstep; const char* cB = (const char*)g.Bt + (size_t)cur.pn * tstep;
    S.a_ready(cur);
    PG8_STAGE(PG8_SB(0, 0), cB, voffB); PG8_STAGE(PG8_SA(0, 0), cA, voffA); PG8_STAGE(PG8_SB(0, 1), cB + hstep, voffB); PG8_STAGE(PG8_SA(0, 1), cA + hstep, voffA);
    if (wr == 1) PG8_BAR;
    PG8_WAIT_V(4); PG8_BAR;
    PG8_STAGE(PG8_SB(1, 0), cB + kstep, voffB); PG8_STAGE(PG8_SA(1, 0), cA + kstep, voffA); PG8_STAGE(PG8_SB(1, 1), cB + hstep + kstep, voffB);
    PG8_WAIT_V(6); PG8_BAR;
    for (;;) {
        const bool has_next = S.next(ui + 1, nxt);
        const char* nA = has_next ? (const char*)g.A + (size_t)nxt.pm * tstep : cA; const char* nB = has_next ? (const char*)g.Bt + (size_t)nxt.pn * tstep : cB;
        for (int t = 0; t < nt; t += 2) {
            const bool last = (t == nt - 2);
            const char* a1 = cA + (size_t)(t + 1) * kstep;
            const char* a2 = last ? nA : cA + (size_t)(t + 2) * kstep; const char* b2 = last ? nB : cB + (size_t)(t + 2) * kstep;
            const char* a3 = a2 + kstep; const char* b3 = b2 + kstep;
            if (last && has_next) S.a_ready(nxt);
            PG8_LDB(B0, 0, 0); PG8_SCHED; PG8_LDA(At, 0, 0); PG8_STAGE(PG8_SA(1, 1), a1 + hstep, voffA);
            PG8_WAIT_L(8); PG8_BAR; PG8_WAIT_L(0); PG8_MMA(0, 0, At, B0); PG8_BAR; PG8_SCHED;
            PG8_LDB(B1, 0, 1); PG8_STAGE(PG8_SB(0, 0), b2, voffB);
            PG8_BAR; PG8_WAIT_L(0); PG8_MMA(0, 1, At, B1); PG8_BAR;
            PG8_LDA(At, 0, 1); PG8_STAGE(PG8_SA(0, 0), a2, voffA);
            PG8_BAR; PG8_WAIT_L(0); PG8_MMA(1, 0, At, B0); PG8_BAR; PG8_SCHED;
            PG8_STAGE(PG8_SB(0, 1), b2 + hstep, voffB);
            PG8_WAIT_V(6); PG8_BAR; PG8_MMA(1, 1, At, B1); PG8_BAR;
            PG8_LDB(B0, 1, 0); PG8_SCHED; PG8_LDA(At, 1, 0); PG8_STAGE(PG8_SA(0, 1), a2 + hstep, voffA);
            PG8_WAIT_L(8); PG8_BAR; PG8_WAIT_L(0); PG8_MMA(0, 0, At, B0); PG8_BAR; PG8_SCHED;
            PG8_LDB(B1, 1, 1); PG8_STAGE(PG8_SB(1, 0), b3, voffB);
            PG8_BAR; PG8_WAIT_L(0); PG8_MMA(0, 1, At, B1); PG8_BAR;
            PG8_LDA(At, 1, 1); PG8_STAGE(PG8_SA(1, 0), a3, voffA);
            PG8_BAR; PG8_WAIT_L(0); PG8_MMA(1, 0, At, B0); PG8_BAR; PG8_SCHED;
            PG8_STAGE(PG8_SB(1, 1), b3 + hstep, voffB);
            PG8_WAIT_V(6); PG8_BAR; PG8_MMA(1, 1, At, B1); PG8_BAR;
        }
        E(acc, cur, wr, wc, fr, fq); S.done(cur);
        if (!has_next) break;
#pragma unroll
        for (int a = 0; a < 2; ++a)
#pragma unroll
            for (int b = 0; b < 2; ++b)
#pragma unroll
                for (int m = 0; m < 4; ++m)
#pragma unroll
                    for (int n = 0; n < 2; ++n) acc[a][b][m][n] = (f32x4){0.f, 0.f, 0.f, 0.f};
        cur = nxt; cA = nA; cB = nB; ++ui;
    }
    PG8_WAIT_V(0);
    if (wr == 0) PG8_BAR;
    PG8_BAR;
#undef PG8_SA
#undef PG8_SB
#undef PG8_STAGE
#undef PG8_LDA
#undef PG8_LDB
#undef PG8_MMA
#undef PG8_WAIT_V
#undef PG8_WAIT_L
#undef PG8_BAR
#undef PG8_SCHED
}
}

__device__ void ph_prep_small(const Params& p) {
    const int gtid = blockIdx.x * blockDim.x + threadIdx.x, gsz = gridDim.x * blockDim.x;
    float* rc = (float*)(p.ws + WS_ROPEC); float* rs = (float*)(p.ws + WS_ROPES); float* lb = (float*)(p.ws + WS_LB); float* mod = (float*)(p.ws + WS_MOD);
    for (int i = gtid; i < 2048 * 32; i += gsz) {
        const int t = i >> 5, k = i & 31;
        const float inv = exp2f(-(float)k * (13.287712379549449f / 32.0f));
        const float ang = (float)t * inv;
        const double a = (double)ang; const double n = rint(a * 0.15915494309189535); const float r = (float)(a - n * 6.283185307179586);
        rc[i] = cosf(r); rs[i] = sinf(r);
    }
    for (int i = gtid; i < 512; i += gsz) { const float a = p.lb_logits[i], b = p.lb_logits[512 + i]; const float m = fmaxf(a, b); const float ea = expf(a - m), eb = expf(b - m); lb[i] = ea / (ea + eb); }
    for (int i = gtid; i < 16 * 6144; i += gsz) {
        const int b = i / 6144, j = i % 6144; float acc = 0.f;
        for (int k = 0; k < 1024; ++k) { const float c = p.c[b * 1024 + k]; const float cs = c / (1.0f + expf(-c)); acc += cs * p.w_ada[(size_t)k * 6144 + j]; }
        mod[i] = acc + p.b_ada[j];
    }
}

__device__ __forceinline__ int proj_src_col(int c) {
    if (c < 1280) return c;
    if (c < 5376) return c + 24;
    if (c < 5400) return 1280 + (c - 5376);
    return -1;
}
__device__ void ph_convert_weights(const Params& p) {
    const size_t gtid = (size_t)blockIdx.x * blockDim.x + threadIdx.x, gsz = (size_t)gridDim.x * blockDim.x;
    bf16_t* win = (bf16_t*)(p.ws + WS_WIN); bf16_t* wb = (bf16_t*)(p.ws + WS_WB); bf16_t* wo = (bf16_t*)(p.ws + WS_WOUT); bf16_t* wq = (bf16_t*)(p.ws + WS_WQ);
    bf16_t* ub = (bf16_t*)(p.ws + WS_U); bf16_t* vb = (bf16_t*)(p.ws + WS_V);
    for (size_t i = gtid; i < (size_t)NPROJ * 1024; i += gsz) { const int n = (int)(i >> 10), k = (int)(i & 1023); const int s = proj_src_col(n); win[i] = s >= 0 ? f2bf(p.w_in[(size_t)k * IN_COLS + s]) : (bf16_t)0; }
    for (size_t i = gtid; i < (size_t)2 * 1024 * 512; i += gsz) { const int br = (int)(i >> 19), n = (int)((i >> 9) & 1023), k = (int)(i & 511); wb[i] = f2bf(p.w_branch[((size_t)br * 512 + k) * 1024 + n]); }
    for (size_t i = gtid; i < (size_t)1024 * 1024; i += gsz) { const int n = (int)(i >> 10), k = (int)(i & 1023); wo[i] = f2bf(p.w_out[(size_t)k * 1024 + n]); }
    for (size_t i = gtid; i < (size_t)2048 * 1024; i += gsz) { const int n = (int)(i >> 10), k = (int)(i & 1023); wq[i] = f2bf(p.w_peer_q[(size_t)k * 2048 + n]); }
    for (size_t i = gtid; i < (size_t)16384 * 1024 / 4; i += gsz) {
        const float4 a = ((const float4*)p.peer_u)[i], b = ((const float4*)p.peer_v)[i];
        ((uint2*)ub)[i] = make_uint2(pack2bf(a.x, a.y), pack2bf(a.z, a.w)); ((uint2*)vb)[i] = make_uint2(pack2bf(b.x, b.y), pack2bf(b.z, b.w));
    }
}

__device__ void ph_rmsnorm_mod(const float* x, const float* g, const float* mod, int sh_off, int sc_off, bf16_t* out) {
    const int wave = threadIdx.x >> 6, lane = threadIdx.x & 63, wpb = blockDim.x >> 6;
    for (int row = blockIdx.x * wpb + wave; row < NTOK; row += gridDim.x * wpb) {
        const float4* xr = (const float4*)(x + (size_t)row * 1024);
        float4 v[4]; float ss = 0.f;
#pragma unroll
        for (int i = 0; i < 4; ++i) { v[i] = xr[lane + 64 * i]; ss += v[i].x * v[i].x + v[i].y * v[i].y + v[i].z * v[i].z + v[i].w * v[i].w; }
        ss = wave_sum(ss);
        const float rstd = rsqrtf(ss * (1.0f / 1024.0f) + 1e-6f);
        const float* mb = mod + (row >> 11) * 6144;
#pragma unroll
        for (int i = 0; i < 4; ++i) {
            const int col = (lane + 64 * i) * 4;
            const float4 gg = *(const float4*)(g + col), sc = *(const float4*)(mb + sc_off + col), sh = *(const float4*)(mb + sh_off + col);
            const float o0 = v[i].x * rstd * gg.x * (1.0f + sc.x) + sh.x, o1 = v[i].y * rstd * gg.y * (1.0f + sc.y) + sh.y;
            const float o2 = v[i].z * rstd * gg.z * (1.0f + sc.z) + sh.z, o3 = v[i].w * rstd * gg.w * (1.0f + sc.w) + sh.w;
            *(uint2*)(out + (size_t)row * 1024 + col) = make_uint2(pack2bf(o0, o1), pack2bf(o2, o3));
        }
    }
}

__device__ void ph_rope(const Params& p) {
    bf16_t* PA = (bf16_t*)(p.ws + WS_PA); const float* rc = (const float*)(p.ws + WS_ROPEC); const float* rs = (const float*)(p.ws + WS_ROPES);
    const size_t gtid = (size_t)blockIdx.x * blockDim.x + threadIdx.x, gsz = (size_t)gridDim.x * blockDim.x;
    for (size_t i = gtid; i < (size_t)NTOK * 14 * 32; i += gsz) {
        const int k = (int)(i & 31); const int hh = (int)((i >> 5) % 14); const size_t tok = (i >> 5) / 14; const int t = (int)(tok & 2047);
        int col;
        if (hh < 8) col = hh * 64; else if (hh < 10) col = 512 + (hh - 8) * 64; else if (hh < 12) col = 768 + (hh - 10) * 64; else col = 1024 + (hh - 12) * 64;
        bf16_t* ptr = PA + tok * 1280 + col;
        const float x1 = bf2f(ptr[k]), x2 = bf2f(ptr[k + 32]); const float c = rc[t * 32 + k], s = rs[t * 32 + k];
        ptr[k] = f2bf(x1 * c - x2 * s); ptr[k + 32] = f2bf(x2 * c + x1 * s);
    }
}

__device__ void ph_compress(const Params& p, float* smem) {
    const bf16_t* PA = (const bf16_t*)(p.ws + WS_PA);
    float* flat = smem; float* hid = smem + 2048;
    for (int item = blockIdx.x; item < 16 * 127 * 2 * 2; item += gridDim.x) {
        const int which = item & 1, g = (item >> 1) & 1, n = (item >> 2) % 127, b = (item >> 2) / 127;
        const float* pos = which ? p.cmp_pos_v : p.cmp_pos_k; const float* w1 = which ? p.w_cv1 : p.w_ck1; const float* w2 = which ? p.w_cv2 : p.w_ck2;
        const int coloff = (which ? 640 : 512) + g * 64;
        __syncthreads();
        for (int i = threadIdx.x; i < 2048; i += blockDim.x) { const int ps = i >> 6, d = i & 63; flat[i] = bf2f(PA[((size_t)b * 2048 + n * 16 + ps) * 1280 + coloff + d]) + pos[ps * 64 + d]; }
        __syncthreads();
        if (threadIdx.x < 128) { float a = 0.f; for (int i = 0; i < 2048; ++i) a += flat[i] * w1[(size_t)i * 128 + threadIdx.x]; hid[threadIdx.x] = gelu_tanh(a); }
        __syncthreads();
        if (threadIdx.x < 64) { float a = 0.f; for (int j = 0; j < 128; ++j) a += hid[j] * w2[j * 64 + threadIdx.x];
            float* dst = (float*)(p.ws + (which ? WS_VCMP : WS_KCMP)); dst[(((size_t)b * 127 + n) * 2 + g) * 64 + threadIdx.x] = a; }
    }
}

__device__ __forceinline__ void attn_block(const float* qs, float* ps, const bf16_t* kvb, int key0, int koff, int voff, int lo, int t, int lane, float (&m)[4], float (&l)[4], float (&acc)[4]) {
    const int key = key0 + lane; const bool valid = (key <= t) && (key >= lo);
    float s[4] = {-INFINITY, -INFINITY, -INFINITY, -INFINITY};
    if (valid) {
        const uint4* kr = (const uint4*)(kvb + (size_t)key * 1280 + koff);
        float a0 = 0.f, a1 = 0.f, a2 = 0.f, a3 = 0.f;
#pragma unroll
        for (int c = 0; c < 8; ++c) { const uint4 w = kr[c]; const unsigned ww[4] = {w.x, w.y, w.z, w.w};
#pragma unroll
            for (int j = 0; j < 4; ++j) { const float k0 = __uint_as_float(ww[j] << 16), k1 = __uint_as_float(ww[j] & 0xffff0000u); const int d = c * 8 + j * 2;
                a0 += qs[d] * k0 + qs[d + 1] * k1; a1 += qs[64 + d] * k0 + qs[64 + d + 1] * k1; a2 += qs[128 + d] * k0 + qs[128 + d + 1] * k1; a3 += qs[192 + d] * k0 + qs[192 + d + 1] * k1; } }
        s[0] = a0 * 0.125f; s[1] = a1 * 0.125f; s[2] = a2 * 0.125f; s[3] = a3 * 0.125f;
    }
#pragma unroll
    for (int r = 0; r < 4; ++r) {
        const float bm = wave_max(s[r]); const float mn = fmaxf(m[r], bm); const float alpha = __expf(m[r] - mn);
        const float pr = valid ? __expf(s[r] - mn) : 0.f;
        l[r] = l[r] * alpha + wave_sum(pr); acc[r] *= alpha; m[r] = mn; ps[r * 64 + lane] = pr;
    }
    wave_lds_sync();
    const int kmax = min(64, t - key0 + 1);
    for (int kk = 0; kk < kmax; ++kk) { const float vv = bf2f(kvb[(size_t)(key0 + kk) * 1280 + voff + lane]);
        acc[0] += ps[kk] * vv; acc[1] += ps[64 + kk] * vv; acc[2] += ps[128 + kk] * vv; acc[3] += ps[192 + kk] * vv; }
    wave_lds_sync();
}
__device__ void ph_attn_simple(const Params& p, float* smem) {
    const bf16_t* PA = (const bf16_t*)(p.ws + WS_PA); const bf16_t* PG = (const bf16_t*)(p.ws + WS_PG);
    const float* kcmp = (const float*)(p.ws + WS_KCMP); const float* vcmp = (const float*)(p.ws + WS_VCMP);
    bf16_t* onsa = (bf16_t*)(p.ws + WS_ONSA);
    const int wave = threadIdx.x >> 6, lane = threadIdx.x & 63, nw = blockDim.x >> 6;
    float* qs = smem + wave * 768; float* ps = qs + 256;
    for (int item = blockIdx.x * nw + wave; item < NTOK * 2; item += gridDim.x * nw) {
        const int g = item & 1, t = (item >> 1) & 2047, b = item >> 12; const size_t tok = (size_t)b * 2048 + t;
        const bf16_t* kvb = PA + (size_t)b * 2048 * 1280;
        wave_lds_sync();
#pragma unroll
        for (int r = 0; r < 4; ++r) qs[r * 64 + lane] = bf2f(PA[tok * 1280 + (g * 4 + r) * 64 + lane]);
        wave_lds_sync();
        const int nv = (t >= 31) ? ((t - 31) >> 4) + 1 : 0;
        float oc[4] = {0.f, 0.f, 0.f, 0.f};
        {
            float s0[4], s1[4];
#pragma unroll
            for (int r = 0; r < 4; ++r) { s0[r] = -INFINITY; s1[r] = -INFINITY; }
#pragma unroll
            for (int hf = 0; hf < 2; ++hf) { const int n = lane + 64 * hf;
                if (n < nv) { const float* kr = kcmp + (((size_t)b * 127 + n) * 2 + g) * 64; float a[4] = {0.f, 0.f, 0.f, 0.f};
                    for (int d = 0; d < 64; ++d) { const float kd = kr[d]; a[0] += qs[d] * kd; a[1] += qs[64 + d] * kd; a[2] += qs[128 + d] * kd; a[3] += qs[192 + d] * kd; }
#pragma unroll
                    for (int r = 0; r < 4; ++r) { if (hf == 0) s0[r] = a[r] * 0.125f; else s1[r] = a[r] * 0.125f; } } }
#pragma unroll
            for (int r = 0; r < 4; ++r) {
                float mx = wave_max(fmaxf(s0[r], s1[r])); if (!(mx > -INFINITY)) mx = 0.f;
                const float e0 = (lane < nv) ? __expf(s0[r] - mx) : 0.f, e1 = (lane + 64 < nv) ? __expf(s1[r] - mx) : 0.f;
                const float sum = fmaxf(wave_sum(e0 + e1), 1e-30f);
                ps[r * 128 + lane] = e0 / sum; ps[r * 128 + 64 + lane] = e1 / sum;
            }
            wave_lds_sync();
            for (int n = 0; n < nv; ++n) { const float vv = vcmp[(((size_t)b * 127 + n) * 2 + g) * 64 + lane];
                oc[0] += ps[n] * vv; oc[1] += ps[128 + n] * vv; oc[2] += ps[256 + n] * vv; oc[3] += ps[384 + n] * vv; }
        }
        unsigned selmask;
        {
            float imp = 0.f;
            if (lane < 32) {
#pragma unroll
                for (int dn = 0; dn < 5; ++dn) { const int n = 4 * lane + dn; if (n < 127) { const float w = (dn == 0 || dn == 4) ? 1.f : 2.f; imp += w * (ps[n] + ps[128 + n] + ps[256 + n] + ps[384 + n]); } }
            }
            const int cur = t >> 6; const bool causal = (lane * 64 <= t);
            float val = -2.f;
            if (lane < 32) { const bool forced = (lane == 0) || (lane == cur) || (lane == cur - 1); val = imp + (forced ? 1000.f : 0.f); if (!causal) val = -1.f; }
            int rank = 0;
            for (int i = 0; i < 32; ++i) { const float vi = __shfl(val, i); rank += ((vi > val) || (vi == val && i < lane)) ? 1 : 0; }
            const bool sel = (lane < 32) && (rank < 16) && causal;
            selmask = (unsigned)__ballot(sel);
        }
        wave_lds_sync();
        float os_[4];
        {
            float m[4] = {-INFINITY, -INFINITY, -INFINITY, -INFINITY}, l[4] = {0.f, 0.f, 0.f, 0.f}, acc[4] = {0.f, 0.f, 0.f, 0.f};
            for (int j = 0; j < 32; ++j) if ((selmask >> j) & 1u) attn_block(qs, ps, kvb, j * 64, 768 + g * 64, 896 + g * 64, 0, t, lane, m, l, acc);
#pragma unroll
            for (int r = 0; r < 4; ++r) os_[r] = acc[r] / fmaxf(l[r], 1e-30f);
        }
        float ow[4];
        {
            float m[4] = {-INFINITY, -INFINITY, -INFINITY, -INFINITY}, l[4] = {0.f, 0.f, 0.f, 0.f}, acc[4] = {0.f, 0.f, 0.f, 0.f};
            const int lo = max(0, t - 511);
            for (int k0 = lo & ~63; k0 <= t; k0 += 64) attn_block(qs, ps, kvb, k0, 1024 + g * 64, 1152 + g * 64, lo, t, lane, m, l, acc);
#pragma unroll
            for (int r = 0; r < 4; ++r) ow[r] = acc[r] / fmaxf(l[r], 1e-30f);
        }
#pragma unroll
        for (int r = 0; r < 4; ++r) { const int h = g * 4 + r; const bf16_t* gl = PG + tok * 256 + h * 3;
            const float o = sigmoidf_(bf2f(gl[0])) * oc[r] + sigmoidf_(bf2f(gl[1])) * os_[r] + sigmoidf_(bf2f(gl[2])) * ow[r];
            onsa[tok * 512 + h * 64 + lane] = f2bf(o); }
    }
}

__device__ void ph_hgrn_simple(const Params& p, float* smem, float* hraw) {
    const bf16_t* PH = (const bf16_t*)(p.ws + WS_PH); const float* lb = (const float*)(p.ws + WS_LB);
    const int wave = threadIdx.x >> 6, lane = threadIdx.x & 63, nw = blockDim.x >> 6;
    float* fs = smem + wave * 2048; float* qsm = fs + 1024;
    for (int item = blockIdx.x * nw + wave; item < 128; item += gridDim.x * nw) {
        const int half = item & 1, h = (item >> 1) & 3, b = item >> 3; const int e = half * 64 + lane;
        float S[128];
#pragma unroll
        for (int d = 0; d < 128; ++d) S[d] = 0.f;
        const float lb0 = lb[h * 128 + lane], lb1 = lb[h * 128 + 64 + lane];
        for (int t0 = 0; t0 < 2048; t0 += 8) {
            wave_lds_sync();
#pragma unroll
            for (int i = 0; i < 8; ++i) { const bf16_t* ph = PH + ((size_t)b * 2048 + t0 + i) * 2048;
                const float hq0 = bf2f(ph[h * 128 + lane]), hq1 = bf2f(ph[h * 128 + 64 + lane]), hf0 = bf2f(ph[512 + h * 128 + lane]), hf1 = bf2f(ph[512 + h * 128 + 64 + lane]);
                fs[i * 128 + lane] = lb0 + (1.0f - lb0) * sigmoidf_(hf0); fs[i * 128 + 64 + lane] = lb1 + (1.0f - lb1) * sigmoidf_(hf1);
                qsm[i * 128 + lane] = hq0 * sigmoidf_(hq0); qsm[i * 128 + 64 + lane] = hq1 * sigmoidf_(hq1); }
            wave_lds_sync();
            for (int i = 0; i < 8; ++i) { const size_t tok = (size_t)b * 2048 + t0 + i; const float ve = bf2f(PH[tok * 2048 + 1024 + h * 128 + e]); float o = 0.f;
#pragma unroll
                for (int d = 0; d < 128; ++d) { const float f = fs[i * 128 + d], q = qsm[i * 128 + d]; S[d] = f * S[d] + (1.0f - f) * ve; o += q * S[d]; }
                hraw[tok * 512 + h * 128 + e] = o; }
        }
    }
}
__device__ void ph_hgrn_post(const Params& p, const float* hraw) {
    const bf16_t* PH = (const bf16_t*)(p.ws + WS_PH); bf16_t* oh = (bf16_t*)(p.ws + WS_OHGRN);
    const int wave = threadIdx.x >> 6, lane = threadIdx.x & 63, nw = blockDim.x >> 6;
    for (int item = blockIdx.x * nw + wave; item < NTOK * 4; item += gridDim.x * nw) {
        const size_t tok = item >> 2; const int h = item & 3;
        const float2 o = *(const float2*)(hraw + tok * 512 + h * 128 + lane * 2);
        const float ss = wave_sum(o.x * o.x + o.y * o.y); const float rstd = rsqrtf(ss * (1.0f / 128.0f) + 1e-6f);
        const unsigned hgw = *(const unsigned*)(PH + tok * 2048 + 1536 + h * 128 + lane * 2);
        const float g0 = __uint_as_float(hgw << 16), g1 = __uint_as_float(hgw & 0xffff0000u);
        const float r0 = o.x * rstd * p.out_norm[lane * 2] * (g0 * sigmoidf_(g0)), r1 = o.y * rstd * p.out_norm[lane * 2 + 1] * (g1 * sigmoidf_(g1));
        *(unsigned*)(oh + tok * 512 + h * 128 + lane * 2) = pack2bf(r0, r1);
    }
}

__device__ __forceinline__ void wave_argmax(float& v, int& i) {
    for (int o = 32; o >= 1; o >>= 1) { const float ov = __shfl_xor(v, o); const int oi = __shfl_xor(i, o); if (ov > v || (ov == v && oi < i)) { v = ov; i = oi; } }
}
__device__ void ph_peer_simple(const Params& p, float* smem) {
    const float* Q = (const float*)(p.ws + WS_Q); const bf16_t* h2 = (const bf16_t*)(p.ws + WS_HBF); const bf16_t* ub = (const bf16_t*)(p.ws + WS_U); const bf16_t* vb = (const bf16_t*)(p.ws + WS_V);
    const float* mod = (const float*)(p.ws + WS_MOD);
    const int wave = threadIdx.x >> 6, lane = threadIdx.x & 63, nw = blockDim.x >> 6;
    float* qrow = smem + wave * 2816; float* topv = qrow + 2048; int* topi = (int*)(topv + 256); int* exi = topi + 256; float* exw = (float*)(exi + 128);
    for (int tok = blockIdx.x * nw + wave; tok < NTOK; tok += gridDim.x * nw) {
        wave_lds_sync();
        for (int i = lane; i < 512; i += 64) ((float4*)qrow)[i] = ((const float4*)(Q + (size_t)tok * 2048))[i];
        wave_lds_sync();
        for (int hp = 0; hp < 16; ++hp) { const int h = hp >> 1, pp = hp & 1;
            const float* qv = qrow + h * 256 + pp * 128;
            float s[2];
#pragma unroll
            for (int j = 0; j < 2; ++j) { const float4* kr = (const float4*)(p.sub_keys + (((size_t)pp * 8 + h) * 128 + lane + 64 * j) * 128); float a = 0.f;
                for (int d = 0; d < 32; ++d) { const float4 kk = kr[d]; a += qv[4 * d] * kk.x + qv[4 * d + 1] * kk.y + qv[4 * d + 2] * kk.z + qv[4 * d + 3] * kk.w; }
                s[j] = a; }
            for (int k = 0; k < 16; ++k) {
                float bv; int bi; if (s[0] >= s[1]) { bv = s[0]; bi = lane; } else { bv = s[1]; bi = lane + 64; }
                wave_argmax(bv, bi);
                if (lane == 0) { topv[hp * 16 + k] = bv; topi[hp * 16 + k] = bi; }
                if (bi == lane) s[0] = -INFINITY; if (bi == lane + 64) s[1] = -INFINITY;
            }
        }
        wave_lds_sync();
        for (int h = 0; h < 8; ++h) {
            float cv[4];
#pragma unroll
            for (int j = 0; j < 4; ++j) { const int c = lane * 4 + j; cv[j] = topv[(h * 2) * 16 + (c >> 4)] + topv[(h * 2 + 1) * 16 + (c & 15)]; }
            float mx = 0.f, gsum = 0.f, myv = 0.f; int myc = 0;
            for (int k = 0; k < 16; ++k) {
                float bv = cv[0]; int bi = lane * 4;
#pragma unroll
                for (int j = 1; j < 4; ++j) if (cv[j] > bv) { bv = cv[j]; bi = lane * 4 + j; }
                wave_argmax(bv, bi);
                if (k == 0) mx = bv;
                const float e = __expf(bv - mx); gsum += e;
                if (lane == k) { myv = e; myc = bi; }
#pragma unroll
                for (int j = 0; j < 4; ++j) if (bi == lane * 4 + j) cv[j] = -INFINITY;
            }
            if (lane < 16) { exi[h * 16 + lane] = topi[(h * 2) * 16 + (myc >> 4)] * 128 + topi[(h * 2 + 1) * 16 + (myc & 15)]; exw[h * 16 + lane] = myv / gsum; }
        }
        wave_lds_sync();
        float hx[16], y[16];
        { const uint4 a = *(const uint4*)(h2 + (size_t)tok * 1024 + lane * 8), b = *(const uint4*)(h2 + (size_t)tok * 1024 + 512 + lane * 8);
          const unsigned ww[8] = {a.x, a.y, a.z, a.w, b.x, b.y, b.z, b.w};
#pragma unroll
          for (int j = 0; j < 8; ++j) { hx[2 * j] = __uint_as_float(ww[j] << 16); hx[2 * j + 1] = __uint_as_float(ww[j] & 0xffff0000u); } }
#pragma unroll
        for (int j = 0; j < 16; ++j) y[j] = 0.f;
        for (int k = 0; k < 128; ++k) {
            const int e = exi[k]; const float gw = exw[k];
            const uint4 ua = *(const uint4*)(ub + (size_t)e * 1024 + lane * 8), ubb = *(const uint4*)(ub + (size_t)e * 1024 + 512 + lane * 8);
            const unsigned uw[8] = {ua.x, ua.y, ua.z, ua.w, ubb.x, ubb.y, ubb.z, ubb.w};
            float a = 0.f;
#pragma unroll
            for (int j = 0; j < 8; ++j) a += hx[2 * j] * __uint_as_float(uw[j] << 16) + hx[2 * j + 1] * __uint_as_float(uw[j] & 0xffff0000u);
            a = wave_sum(a);
            const float w = gw * gelu_tanh(a);
            const uint4 va = *(const uint4*)(vb + (size_t)e * 1024 + lane * 8), vbb = *(const uint4*)(vb + (size_t)e * 1024 + 512 + lane * 8);
            const unsigned vw[8] = {va.x, va.y, va.z, va.w, vbb.x, vbb.y, vbb.z, vbb.w};
#pragma unroll
            for (int j = 0; j < 8; ++j) { y[2 * j] += w * __uint_as_float(vw[j] << 16); y[2 * j + 1] += w * __uint_as_float(vw[j] & 0xffff0000u); }
        }
        const float* gt = mod + (tok >> 11) * 6144 + 5120;
        float xf[16]; float ss = 0.f;
#pragma unroll
        for (int hf = 0; hf < 2; ++hf) { const int col = hf * 512 + lane * 8;
#pragma unroll
            for (int j = 0; j < 8; ++j) { const float v = p.out[(size_t)tok * 1024 + col + j] + gt[col + j] * y[hf * 8 + j]; xf[hf * 8 + j] = v; ss += v * v; } }
        ss = wave_sum(ss); const float rstd = rsqrtf(ss * (1.0f / 1024.0f) + 1e-6f);
#pragma unroll
        for (int hf = 0; hf < 2; ++hf) { const int col = hf * 512 + lane * 8;
#pragma unroll
            for (int j = 0; j < 8; ++j) p.out[(size_t)tok * 1024 + col + j] = xf[hf * 8 + j] * rstd * p.g_final[col + j]; }
    }
}

extern __shared__ __attribute__((aligned(16))) unsigned char dyn_smem[];
__global__ void __launch_bounds__(512) k_prep_small(Params p) { ph_prep_small(p); }
__global__ void __launch_bounds__(512) k_convert(Params p) { ph_convert_weights(p); }
__global__ void __launch_bounds__(512) k_norm1(Params p) { ph_rmsnorm_mod(p.x, p.g_mix, (const float*)(p.ws + WS_MOD), 0, 1024, (bf16_t*)(p.ws + WS_HBF)); }
__global__ void __launch_bounds__(512) k_norm2(Params p) { ph_rmsnorm_mod(p.out, p.g_ffn, (const float*)(p.ws + WS_MOD), 3072, 4096, (bf16_t*)(p.ws + WS_HBF)); }
__global__ void __launch_bounds__(512) k_rope(Params p) { ph_rope(p); }
__global__ void __launch_bounds__(512) k_compress(Params p) { ph_compress(p, (float*)dyn_smem); }
__global__ void __launch_bounds__(512) k_attn(Params p) { ph_attn_simple(p, (float*)dyn_smem); }
__global__ void __launch_bounds__(64) k_hgrn(Params p) { ph_hgrn_simple(p, (float*)dyn_smem, p.out); }
__global__ void __launch_bounds__(512) k_hgrn_post(Params p) { ph_hgrn_post(p, p.out); }
__global__ void __launch_bounds__(512) k_peer(Params p) { ph_peer_simple(p, (float*)dyn_smem); }
template <class Epi> __global__ void __launch_bounds__(512, 2) k_gemm(pg8::Gemm g, Epi E) {
    pg8::StaticOrder S; S.init(g.M, g.N, (int)gridDim.x, (int)blockIdx.x);
    pg8::gemm_phase<Epi, pg8::StaticOrder>((LAS unsigned char*)dyn_smem, g, S, E);
}
template <class Epi> static void launch_gemm(const pg8::Gemm& g, const Epi& E, hipStream_t st) {
    static bool attr = false; if (!attr) { (void)hipFuncSetAttribute((const void*)k_gemm<Epi>, hipFuncAttributeMaxDynamicSharedMemorySize, pg8::STAGE_BYTES); attr = true; }
    hipLaunchKernelGGL((k_gemm<Epi>), dim3(256), dim3(512), pg8::STAGE_BYTES, st, g, E);
}

extern "C" void kernel_launch(void* const* d_in, const int* in_sizes, int n_in, void* d_out, int out_size, void* d_ws, size_t ws_size, hipStream_t stream) {
    if (ws_size < WS_END) { fprintf(stderr, "kernel_launch: workspace too small (%zu < %zu)\n", ws_size, (size_t)WS_END); return; }
    Params p{};
    p.x = (const float*)d_in[0]; p.c = (const float*)d_in[1]; p.w_ada = (const float*)d_in[2]; p.b_ada = (const float*)d_in[3]; p.g_mix = (const float*)d_in[4]; p.g_ffn = (const float*)d_in[5];
    p.w_in = (const float*)d_in[6]; p.cmp_pos_k = (const float*)d_in[7]; p.cmp_pos_v = (const float*)d_in[8]; p.w_ck1 = (const float*)d_in[9]; p.w_ck2 = (const float*)d_in[10];
    p.w_cv1 = (const float*)d_in[11]; p.w_cv2 = (const float*)d_in[12]; p.lb_logits = (const float*)d_in[13]; p.out_norm = (const float*)d_in[14]; p.w_branch = (const float*)d_in[15];
    p.w_out = (const float*)d_in[16]; p.w_peer_q = (const float*)d_in[17]; p.sub_keys = (const float*)d_in[18]; p.peer_u = (const float*)d_in[19]; p.peer_v = (const float*)d_in[20]; p.g_final = (const float*)d_in[21];
    p.out = (float*)d_out; p.ws = (unsigned char*)d_ws;
    unsigned char* ws = p.ws;
    static bool attr = false;
    if (!attr) { (void)hipFuncSetAttribute((const void*)k_peer, hipFuncAttributeMaxDynamicSharedMemorySize, 8 * 2816 * 4); attr = true; }
    hipLaunchKernelGGL(k_prep_small, dim3(256), dim3(512), 0, stream, p);
    hipLaunchKernelGGL(k_convert, dim3(1024), dim3(512), 0, stream, p);
    hipLaunchKernelGGL(k_norm1, dim3(1024), dim3(512), 0, stream, p);
    { pg8::Gemm g{(const bf16_t*)(ws + WS_HBF), (const bf16_t*)(ws + WS_WIN), NTOK, NPROJ, 1024, 0};
      pg8::EpiProj E{(bf16_t*)(ws + WS_PA), (bf16_t*)(ws + WS_PH), (bf16_t*)(ws + WS_PM), (bf16_t*)(ws + WS_PG)}; launch_gemm(g, E, stream); }
    hipLaunchKernelGGL(k_rope, dim3(1024), dim3(512), 0, stream, p);
    hipLaunchKernelGGL(k_compress, dim3(2048), dim3(256), 2176 * 4, stream, p);
    hipLaunchKernelGGL(k_hgrn, dim3(128), dim3(64), 2048 * 4, stream, p);
    hipLaunchKernelGGL(k_hgrn_post, dim3(1024), dim3(512), 0, stream, p);
    hipLaunchKernelGGL(k_attn, dim3(1024), dim3(512), 8 * 768 * 4, stream, p);
    { pg8::Gemm g{(const bf16_t*)(ws + WS_ONSA), (const bf16_t*)(ws + WS_WB), NTOK, 1024, 512, 0};
      pg8::EpiGateA E{(float*)(ws + WS_YA), (const bf16_t*)(ws + WS_PM)}; launch_gemm(g, E, stream); }
    { pg8::Gemm g{(const bf16_t*)(ws + WS_OHGRN), (const bf16_t*)(ws + WS_WB) + 1024 * 512, NTOK, 1024, 512, 0};
      pg8::EpiGateB E{(const float*)(ws + WS_YA), (const bf16_t*)(ws + WS_PM), (bf16_t*)(ws + WS_Y)}; launch_gemm(g, E, stream); }
    { pg8::Gemm g{(const bf16_t*)(ws + WS_Y), (const bf16_t*)(ws + WS_WOUT), NTOK, 1024, 1024, 0};
      pg8::EpiResid E{p.x, (const float*)(ws + WS_MOD), p.out}; launch_gemm(g, E, stream); }
    hipLaunchKernelGGL(k_norm2, dim3(1024), dim3(512), 0, stream, p);
    { pg8::Gemm g{(const bf16_t*)(ws + WS_HBF), (const bf16_t*)(ws + WS_WQ), NTOK, 2048, 1024, 0};
      pg8::EpiF32 E{(float*)(ws + WS_Q), 2048, 0}; launch_gemm(g, E, stream); }
    hipLaunchKernelGGL(k_peer, dim3(1024), dim3(512), 8 * 2816 * 4, stream, p);
}
```

```cpp
#include <hip/hip_runtime.h>
#include <hip/hip_bf16.h>
#include <hip/hip_cooperative_groups.h>
namespace cg = cooperative_groups;
#include <cstdio>
#include <cstdint>

#ifndef PROBE_PHASE
#define PROBE_PHASE -1
#endif
typedef unsigned short bf16_t;
#define LAS __attribute__((address_space(3)))

constexpr int DM = 1024, NB = 16, SEQ = 2048, NTOK = NB * SEQ;
constexpr int IN_COLS = 5400, NPROJ = 5632;
constexpr size_t MiB = 1ull << 20;
constexpr size_t WS_WIN = 0;
constexpr size_t WS_WB = 11 * MiB;
constexpr size_t WS_WOUT = 13 * MiB;
constexpr size_t WS_WQ = 15 * MiB;
constexpr size_t WS_U = 19 * MiB;
constexpr size_t WS_V = 51 * MiB;
constexpr size_t WS_SMALL = 83 * MiB;
constexpr size_t WS_MOD = WS_SMALL;
constexpr size_t WS_ROPEC = WS_MOD + 16 * 6144 * 4;
constexpr size_t WS_ROPES = WS_ROPEC + 2048 * 32 * 4;
constexpr size_t WS_LB = WS_ROPES + 2048 * 32 * 4;
constexpr size_t WS_KCMP = WS_LB + 512 * 4;
constexpr size_t WS_VCMP = WS_KCMP + 16 * 2 * 128 * 64 * 2;
constexpr size_t WS_W1TK = WS_SMALL + 2 * MiB;
constexpr size_t WS_W1TV = WS_SMALL + 3 * MiB;
constexpr size_t WS_C0 = WS_SMALL + 4 * MiB;
constexpr size_t WS_BAR = WS_SMALL + 4 * MiB + 64 * 1024;
constexpr size_t WS_HBF = 88 * MiB;
constexpr size_t WS_ONSA = WS_HBF;
constexpr size_t WS_OHGRN = WS_HBF + 32 * MiB;
constexpr size_t WS_PA = 152 * MiB;
constexpr size_t WS_PH = 232 * MiB;
constexpr size_t WS_PM = 360 * MiB;
constexpr size_t WS_PG = 488 * MiB;
constexpr size_t WS_YA = 152 * MiB;
constexpr size_t WS_Y = 280 * MiB;
constexpr size_t WS_Q = 152 * MiB;
constexpr size_t WS_X1B = 344 * MiB;
constexpr size_t WS_EXI = 408 * MiB;
constexpr size_t WS_EXW = 424 * MiB;
constexpr size_t WS_SU = WS_U + 16 * MiB;
constexpr size_t WS_SV = WS_V + 16 * MiB;
constexpr size_t WS_SUV = WS_SU + 128 * 1024;
constexpr size_t WS_X8 = 440 * MiB;
constexpr size_t WS_SX = 472 * MiB;
constexpr size_t WS_AOUT = 473 * MiB;
constexpr size_t WS_SSP = 489 * MiB;
constexpr size_t WS_END = 504 * MiB;

constexpr size_t DO_KCC = 0, DO_VCC = 9 * MiB, DO_HID = 20 * MiB, DO_HP = 24 * MiB;
struct Params {
    const float* x; const float* c; const float* w_ada; const float* b_ada; const float* g_mix; const float* g_ffn; const float* w_in;
    const float* cmp_pos_k; const float* cmp_pos_v; const float* w_ck1; const float* w_ck2; const float* w_cv1; const float* w_cv2;
    const float* lb_logits; const float* out_norm; const float* w_branch; const float* w_out; const float* w_peer_q; const float* sub_keys;
    const float* peer_u; const float* peer_v; const float* g_final;
    float* out; unsigned char* ws;
};

__device__ __forceinline__ float bf2f(bf16_t v) { return __uint_as_float((unsigned)v << 16); }
__device__ __forceinline__ bf16_t f2bf(float f) { unsigned u = __float_as_uint(f); u += 0x7fffu + ((u >> 16) & 1u); return (bf16_t)(u >> 16); }
__device__ __forceinline__ unsigned pack2bf(float lo, float hi) { return (unsigned)f2bf(lo) | ((unsigned)f2bf(hi) << 16); }
template <int M> __device__ __forceinline__ float xor_get(float v) { return __int_as_float(__builtin_amdgcn_ds_swizzle(__float_as_int(v), (M << 10) | 0x1f)); }
template <int M> __device__ __forceinline__ unsigned xor_getu(unsigned v) { return (unsigned)__builtin_amdgcn_ds_swizzle((int)v, (M << 10) | 0x1f); }
__device__ __forceinline__ float half_sum(float v) { auto rr = __builtin_amdgcn_permlane32_swap(__float_as_uint(v), __float_as_uint(v), false, false); return __uint_as_float(rr[0]) + __uint_as_float(rr[1]); }
__device__ __forceinline__ float half_max(float v) { auto rr = __builtin_amdgcn_permlane32_swap(__float_as_uint(v), __float_as_uint(v), false, false); return fmaxf(__uint_as_float(rr[0]), __uint_as_float(rr[1])); }
__device__ __forceinline__ float half_other(float v) { auto rr = __builtin_amdgcn_permlane32_swap(__float_as_uint(v), __float_as_uint(v), false, false); return __uint_as_float(rr[0] ^ rr[1] ^ __float_as_uint(v)); }
__device__ __forceinline__ float wave_sum(float v) { v = half_sum(v); v += xor_get<16>(v); v += xor_get<8>(v); v += xor_get<4>(v); v += xor_get<2>(v); v += xor_get<1>(v); return v; }
__device__ __forceinline__ float wave_max(float v) { v = half_max(v); v = fmaxf(v, xor_get<16>(v)); v = fmaxf(v, xor_get<8>(v)); v = fmaxf(v, xor_get<4>(v)); v = fmaxf(v, xor_get<2>(v)); v = fmaxf(v, xor_get<1>(v)); return v; }
__device__ __forceinline__ float sigmoidf_(float x) { return __builtin_amdgcn_rcpf(1.0f + __expf(-x)); }
__device__ __forceinline__ float gelu_tanh(float x) { const float u2 = 1.5957691216057308f * (x + 0.044715f * x * x * x); return x * sigmoidf_(u2); }
__device__ __forceinline__ int fresh_tid() { int w = __builtin_amdgcn_readfirstlane(threadIdx.x >> 6); asm volatile("" : "+s"(w)); int l = __builtin_amdgcn_mbcnt_hi(~0u, __builtin_amdgcn_mbcnt_lo(~0u, 0)); asm volatile("" : "+v"(l)); return w * 64 + l; }
__device__ __forceinline__ void wave_lds_sync() { asm volatile("s_waitcnt lgkmcnt(0)" ::: "memory"); }

namespace pg8 {
typedef short bf16x8 __attribute__((ext_vector_type(8)));
typedef float f32x4 __attribute__((ext_vector_type(4)));
typedef unsigned u32x4 __attribute__((ext_vector_type(4)));
typedef unsigned u32x2 __attribute__((ext_vector_type(2)));
constexpr int BM = 256, BK = 64, HALF = 128, HTB = HALF * BK * 2, STAGE_BYTES = 8 * HTB, NXCD = 8, WGM = 8;
__host__ __device__ __forceinline__ int lds_byte(int r, int c) { const int st = (r >> 4) * 2 + (c >> 5), rr = r & 15, cc = c & 31, ob = rr * 64 + cc * 2; return st * 1024 + (ob ^ (((ob >> 9) & 1) << 5)); }
__host__ __device__ __forceinline__ void stage_rc(int b, int& R, int& C) { const int st = b / 1024, sb = b % 1024, swz = sb ^ (((sb >> 9) & 1) << 5); R = (st >> 1) * 16 + swz / 64; C = (st & 1) * 32 + (swz % 64) / 2; }
__host__ __device__ __forceinline__ int perm32(int rho) { const int n = rho >> 4, i = rho & 15; return 8 * (i >> 2) + 4 * n + (i & 3); }
struct Unit { int pm, pn; };
struct Gemm { const bf16_t* A; const bf16_t* Bt; int M, N, K, lda; };
struct StaticOrder {
    int nM, nN, nwg, G, c;
    __host__ __device__ __forceinline__ void init(int M, int N, int G_, int c_) { nM = M / BM; nN = N / BM; nwg = nM * nN; G = G_; c = c_; }
    __host__ __device__ __forceinline__ bool next(int i, Unit& u) const {
        const long L = (long)i * G + c; if (L >= nwg) return false;
        int wgid = (int)L; { const int q = nwg / NXCD, r = nwg % NXCD, xcd = wgid % NXCD, off = wgid / NXCD; wgid = (xcd < r ? xcd * (q + 1) : r * (q + 1) + (xcd - r) * q) + off; }
        const int nig = WGM * nN, gid = wgid / nig, fm = gid * WGM, gsz = (nM - fm) < WGM ? (nM - fm) : WGM;
        u.pm = fm + ((wgid % nig) % gsz); u.pn = (wgid % nig) / gsz; return true;
    }
    __device__ __forceinline__ void a_ready(const Unit&) const {}
    __device__ __forceinline__ void done(const Unit&) const {}
};
__device__ __forceinline__ unsigned cvt_pk_bf16(float lo, float hi) { unsigned r; asm volatile("v_cvt_pk_bf16_f32 %0, %1, %2" : "=v"(r) : "v"(lo), "v"(hi)); return r; }

struct EpiF32 {
    static constexpr bool PERM = false, AFTER_DRAIN = false;
    float* C; int ldc; int pad_;
    __device__ __forceinline__ void operator()(const f32x4 (&acc)[2][2][4][2], const Unit& u, int wr, int wc, int fr, int fq) const {
        const int row0 = u.pm * BM + wr * 64 + fr, col0 = u.pn * BM + wc * 32 + 4 * fq;
#pragma unroll
        for (int ai = 0; ai < 2; ++ai)
#pragma unroll
            for (int m = 0; m < 4; ++m) { float* rowp = C + (size_t)(row0 + ai * HALF + m * 16) * ldc + col0;
#pragma unroll
                for (int bj = 0; bj < 2; ++bj)
#pragma unroll
                    for (int n = 0; n < 2; ++n) *(f32x4*)(rowp + bj * HALF + n * 16) = acc[ai][bj][m][n]; }
    }
};
__device__ __forceinline__ unsigned pk_f16(float lo, float hi) { typedef _Float16 h2 __attribute__((ext_vector_type(2))); h2 v = {(_Float16)lo, (_Float16)hi}; return __builtin_bit_cast(unsigned, v); }
struct EpiF16 {
    static constexpr bool PERM = true, AFTER_DRAIN = false;
    bf16_t* O; int ntn; int pad_;
    __device__ __forceinline__ void operator()(const f32x4 (&acc)[2][2][4][2], const Unit& u, int wr, int wc, int fr, int fq) const {
        bf16_t* base = O + (size_t)(u.pm * ntn + u.pn) * 65536 + ((wr * 4 + wc) * 1024 + fq * 16 + fr) * 8;
#pragma unroll
        for (int ai = 0; ai < 2; ++ai)
#pragma unroll
            for (int m = 0; m < 4; ++m)
#pragma unroll
                for (int bj = 0; bj < 2; ++bj) { const f32x4 v0 = acc[ai][bj][m][0], v1 = acc[ai][bj][m][1];
                    u32x4 w; w.x = pk_f16(v0[0], v0[1]); w.y = pk_f16(v0[2], v0[3]); w.z = pk_f16(v1[0], v1[1]); w.w = pk_f16(v1[2], v1[3]);
                    *(u32x4*)(base + ((ai * 4 + m) * 2 + bj) * 512) = w; }
    }
};
struct EpiProj {
    static constexpr bool PERM = true, AFTER_DRAIN = false;
    bf16_t* PA; bf16_t* PH; bf16_t* PM; bf16_t* PG; bf16_t* KCc; bf16_t* VCc; const float* rc; const float* rs;
    __device__ __forceinline__ void operator()(const f32x4 (&acc)[2][2][4][2], const Unit& u, int wr, int wc, int fr, int fq) const {
        const int row0 = u.pm * BM + wr * 64 + fr;
        bf16_t* base; int ldc, colt;
        if (u.pn < 5) { base = PA; ldc = 1280; colt = u.pn * 256; }
        else if (u.pn < 13) { base = PH; ldc = 2048; colt = (u.pn - 5) * 256; }
        else if (u.pn < 21) { base = PM; ldc = 2048; colt = (u.pn - 13) * 256; }
        else { base = PG; ldc = 256; colt = 0; }
        const int col0 = colt + wc * 32 + 8 * fq;
        const int i0 = (wc & 1) * 16 + 4 * fq;
#pragma unroll
        for (int ai = 0; ai < 2; ++ai)
#pragma unroll
            for (int m = 0; m < 4; ++m) { const int row = row0 + ai * HALF + m * 16; bf16_t* rowp = base + (size_t)row * ldc + col0; const int t = row & 2047;
#pragma unroll
                for (int bj = 0; bj < 2; ++bj) { f32x4 v0 = acc[ai][bj][m][0], v1 = acc[ai][bj][m][1];
                    const bool rope = (u.pn < 2) || (u.pn < 5 && bj == 0);
                    if (rope) { const f32x4 c = *(const f32x4*)(rc + t * 32 + i0), sn = *(const f32x4*)(rs + t * 32 + i0);
                        const f32x4 a0 = v0, a1 = v1;
                        v0[0] = a0[0] * c[0] - a0[1] * sn[0]; v0[1] = a0[1] * c[0] + a0[0] * sn[0]; v0[2] = a0[2] * c[1] - a0[3] * sn[1]; v0[3] = a0[3] * c[1] + a0[2] * sn[1];
                        v1[0] = a1[0] * c[2] - a1[1] * sn[2]; v1[1] = a1[1] * c[2] + a1[0] * sn[2]; v1[2] = a1[2] * c[3] - a1[3] * sn[3]; v1[3] = a1[3] * c[3] + a1[2] * sn[3]; }
                    if (u.pn >= 13 && u.pn < 21) {
#pragma unroll
                        for (int q = 0; q < 4; ++q) { v0[q] = sigmoidf_(v0[q]); v1[q] = sigmoidf_(v1[q]); } }
                    u32x4 w; w.x = cvt_pk_bf16(v0[0], v0[1]); w.y = cvt_pk_bf16(v0[2], v0[3]); w.z = cvt_pk_bf16(v1[0], v1[1]); w.w = cvt_pk_bf16(v1[2], v1[3]);
                    if (u.pn >= 5 && u.pn < 21) { bf16_t* tb = (u.pn < 13) ? PH + (size_t)(u.pm * 8 + (u.pn - 5)) * 65536 : PM + (size_t)(u.pm * 8 + (u.pn - 13)) * 65536;
                        *(u32x4*)(tb + (size_t)(wr * 4 + wc) * 8192 + (((ai * 4 + m) * 2 + bj) * 64 + fq * 16 + fr) * 8) = w; }
                    else if (u.pn == 2) { bf16_t* cb = bj ? VCc : KCc; *(u32x4*)(cb + ((size_t)((row >> 11) * 2 + (wc >> 1)) * 2048 + t) * 64 + (wc & 1) * 32 + 8 * fq) = w; }
                    else *(u32x4*)(rowp + bj * HALF) = w; } }
    }
};
struct EpiCompress {
    static constexpr bool PERM = false, AFTER_DRAIN = false;
    bf16_t* HID; const float* c0;
    __device__ __forceinline__ void operator()(const f32x4 (&acc)[2][2][4][2], const Unit& u, int wr, int wc, int fr, int fq) const {
        const int row0 = u.pm * BM + wr * 64 + fr, col0 = wc * 32 + 4 * fq;
#pragma unroll
        for (int ai = 0; ai < 2; ++ai)
#pragma unroll
            for (int m = 0; m < 4; ++m) { const size_t row = (size_t)(row0 + ai * HALF + m * 16);
#pragma unroll
                for (int n = 0; n < 2; ++n) { const int col = col0 + n * 16; const f32x4 bz = *(const f32x4*)(c0 + col); const f32x4 a = acc[ai][0][m][n] + bz;
                    u32x2 w; w.x = cvt_pk_bf16(gelu_tanh(a[0]), gelu_tanh(a[1])); w.y = cvt_pk_bf16(gelu_tanh(a[2]), gelu_tanh(a[3]));
                    *(u32x2*)(HID + row * 128 + col) = w; } }
    }
};
struct EpiBranch {
    static constexpr bool PERM = true, AFTER_DRAIN = false, HAS_MID = true; static constexpr int MID_T = 8;
    const bf16_t* PM; bf16_t* Y;
    __device__ __forceinline__ void mid(f32x4 (&acc)[2][2][4][2], const Unit& u, int wr, int wc, int fr, int fq) const {
        int lo = ((wr * 4 + wc) * 1024 + fq * 16 + fr) * 8;
        asm volatile("" : "+v"(lo));
        const bf16_t* pa = PM + (size_t)(u.pm * 8 + u.pn) * 65536 + lo; const bf16_t* pb = pa + 4 * 65536;
#pragma unroll
        for (int ai = 0; ai < 2; ++ai)
#pragma unroll
            for (int m = 0; m < 4; ++m) {
#pragma unroll
                for (int bj = 0; bj < 2; ++bj) { const int k = (ai * 4 + m) * 2 + bj; const u32x4 ga = *(const u32x4*)(pa + k * 512), gb = *(const u32x4*)(pb + k * 512);
#pragma unroll
                    for (int q = 0; q < 4; ++q) { const float a0 = __uint_as_float(ga[q] << 16), a1 = __uint_as_float(ga[q] & 0xffff0000u), b0 = __uint_as_float(gb[q] << 16), b1 = __uint_as_float(gb[q] & 0xffff0000u);
                        const float r0 = a0 * __builtin_amdgcn_rcpf(b0), r1 = a1 * __builtin_amdgcn_rcpf(b1);
                        acc[ai][bj][m][q >> 1][(q & 1) * 2] *= r0; acc[ai][bj][m][q >> 1][(q & 1) * 2 + 1] *= r1; } }
                if (m & 1) asm volatile("" ::: "memory"); }
    }
    __device__ __forceinline__ void operator()(const f32x4 (&acc)[2][2][4][2], const Unit& u, int wr, int wc, int fr, int fq) const {
        const int row0 = u.pm * BM + wr * 64 + fr, col0 = u.pn * BM + wc * 32 + 8 * fq;
        const bf16_t* pb = PM + (size_t)(u.pm * 8 + 4 + u.pn) * 65536 + ((wr * 4 + wc) * 1024 + fq * 16 + fr) * 8;
#pragma unroll
        for (int ai = 0; ai < 2; ++ai)
#pragma unroll
            for (int m = 0; m < 4; ++m) { const size_t row = (size_t)(row0 + ai * HALF + m * 16);
#pragma unroll
                for (int bj = 0; bj < 2; ++bj) { const u32x4 gb = *(const u32x4*)(pb + ((ai * 4 + m) * 2 + bj) * 512); const f32x4 v0 = acc[ai][bj][m][0], v1 = acc[ai][bj][m][1];
                    u32x4 w;
                    w.x = cvt_pk_bf16(v0[0] * __uint_as_float(gb[0] << 16), v0[1] * __uint_as_float(gb[0] & 0xffff0000u));
                    w.y = cvt_pk_bf16(v0[2] * __uint_as_float(gb[1] << 16), v0[3] * __uint_as_float(gb[1] & 0xffff0000u));
                    w.z = cvt_pk_bf16(v1[0] * __uint_as_float(gb[2] << 16), v1[1] * __uint_as_float(gb[2] & 0xffff0000u));
                    w.w = cvt_pk_bf16(v1[2] * __uint_as_float(gb[3] << 16), v1[3] * __uint_as_float(gb[3] & 0xffff0000u));
                    *(u32x4*)(Y + row * 1024 + col0 + bj * HALF) = w; } }
    }
};
struct EpiResid {
    static constexpr bool PERM = true, AFTER_DRAIN = false;
    const float* X; const float* mod; bf16_t* X1;
    __device__ __forceinline__ void operator()(const f32x4 (&acc)[2][2][4][2], const Unit& u, int wr, int wc, int fr, int fq) const {
        const int row0 = u.pm * BM + wr * 64 + fr, col0 = u.pn * BM + wc * 32 + 8 * fq;
        const int b = (u.pm * BM) >> 11;
#pragma unroll
        for (int ai = 0; ai < 2; ++ai)
#pragma unroll
            for (int m = 0; m < 4; ++m) { const size_t row = (size_t)(row0 + ai * HALF + m * 16);
#pragma unroll
                for (int bj = 0; bj < 2; ++bj) { const int col = col0 + bj * HALF;
                    const f32x4 g0 = *(const f32x4*)(mod + b * 6144 + 2048 + col), g1 = *(const f32x4*)(mod + b * 6144 + 2048 + col + 4);
                    const f32x4 x0 = *(const f32x4*)(X + row * 1024 + col), x1 = *(const f32x4*)(X + row * 1024 + col + 4);
                    const f32x4 r0 = x0 + g0 * acc[ai][bj][m][0], r1 = x1 + g1 * acc[ai][bj][m][1];
                    u32x4 w; w.x = cvt_pk_bf16(r0[0], r0[1]); w.y = cvt_pk_bf16(r0[2], r0[3]); w.z = cvt_pk_bf16(r1[0], r1[1]); w.w = cvt_pk_bf16(r1[2], r1[3]);
                    *(u32x4*)(X1 + row * 1024 + col) = w; } }
    }
};
template <class E_, class = void> struct mid_hook { static constexpr bool value = false; };
template <class E_> struct mid_hook<E_, decltype((void)E_::HAS_MID)> { static constexpr bool value = E_::HAS_MID; };
template <class Epi, class Sched>
__device__ __forceinline__ void gemm_phase(LAS unsigned char* lds, const Gemm g, const Sched& S, const Epi& E) {
    const int tidx = fresh_tid();
    const int tid = tidx, wid = __builtin_amdgcn_readfirstlane(tid >> 6), lane = tid & 63, wr = wid >> 2, wc = wid & 3, fr = lane & 15, fq = lane >> 4;
    const int K = g.K, nt = K / BK;
    unsigned voffA[2], voffB[2];
#pragma unroll
    for (int i = 0; i < 2; ++i) { int R, C; stage_rc(tid * 16 + i * 8192, R, C); const int Rb = Epi::PERM ? ((R & ~31) + perm32(R & 31)) : R;
        voffA[i] = (unsigned)(R * g.lda + C) * 2u; voffB[i] = (unsigned)(Rb * K + C) * 2u; }
    const size_t kstep = (size_t)(BK * 2);
    const size_t hstep = (size_t)HALF * K * 2, hstepA = (size_t)HALF * g.lda * 2;
    const size_t tstep = 2 * hstep, tstepA = 2 * hstepA;
    const unsigned ldsw = (unsigned)wid * 1024u;
    const int aoff = lds_byte(wr * 64 + fr, fq * 8), boff = lds_byte(wc * 32 + fr, fq * 8);
#define PG8_SA(b, h) (((b) * 2 + (h)) * HTB)
#define PG8_SB(b, h) ((4 + (b) * 2 + (h)) * HTB)
#define PG8_STAGE(bufoff, gbase, voff) do { _Pragma("unroll") for (int _i = 0; _i < 2; ++_i) \
        __builtin_amdgcn_global_load_lds((const unsigned*)((const char*)(gbase) + (voff)[_i]), (LAS unsigned*)(lds + (bufoff) + ldsw + _i * 8192), 16, 0, 0); } while (0)
#define PG8_LDA(dst, b, h) do { _Pragma("unroll") for (int m = 0; m < 4; ++m) _Pragma("unroll") for (int k = 0; k < 2; ++k) dst[m][k] = *(const LAS bf16x8*)(lds + PG8_SA(b, h) + aoff + m * 2048 + k * 1024); } while (0)
#define PG8_LDB(dst, b, h) do { _Pragma("unroll") for (int n = 0; n < 2; ++n) _Pragma("unroll") for (int k = 0; k < 2; ++k) dst[n][k] = *(const LAS bf16x8*)(lds + PG8_SB(b, h) + boff + n * 2048 + k * 1024); } while (0)
#define PG8_MMA(ai, bj, At, Bt) do { __builtin_amdgcn_s_setprio(1); _Pragma("unroll") for (int m = 0; m < 4; ++m) _Pragma("unroll") for (int n = 0; n < 2; ++n) _Pragma("unroll") for (int k = 0; k < 2; ++k) \
        acc[ai][bj][m][n] = __builtin_amdgcn_mfma_f32_16x16x32_bf16(Bt[n][k], At[m][k], acc[ai][bj][m][n], 0, 0, 0); __builtin_amdgcn_s_setprio(0); } while (0)
#define PG8_WAIT_V(n) asm volatile("s_waitcnt vmcnt(" #n ")" ::: "memory")
#define PG8_WAIT_L(n) asm volatile("s_waitcnt lgkmcnt(" #n ")" ::: "memory")
#define PG8_BAR __builtin_amdgcn_s_barrier()
#define PG8_SCHED __builtin_amdgcn_sched_barrier(0)
    Unit cur, nxt; int ui = 0;
    if (!S.next(0, cur)) return;
    f32x4 acc[2][2][4][2];
#pragma unroll
    for (int a = 0; a < 2; ++a)
#pragma unroll
        for (int b = 0; b < 2; ++b)
#pragma unroll
            for (int m = 0; m < 4; ++m)
#pragma unroll
                for (int n = 0; n < 2; ++n) acc[a][b][m][n] = (f32x4){0.f, 0.f, 0.f, 0.f};
    bf16x8 At[4][2], B0[2][2], B1[2][2];
    const char* cA = (const char*)g.A + (size_t)cur.pm * tstepA; const char* cB = (const char*)g.Bt + (size_t)cur.pn * tstep;
    S.a_ready(cur);
    PG8_STAGE(PG8_SB(0, 0), cB, voffB); PG8_STAGE(PG8_SB(0, 1), cB + hstep, voffB); PG8_STAGE(PG8_SA(0, 0), cA, voffA); PG8_STAGE(PG8_SA(0, 1), cA + hstepA, voffA);
    if (wr == 1) PG8_BAR;
    PG8_WAIT_V(2); PG8_BAR;
    PG8_STAGE(PG8_SB(1, 0), cB + kstep, voffB); PG8_STAGE(PG8_SA(1, 0), cA + kstep, voffA); PG8_STAGE(PG8_SB(1, 1), cB + hstep + kstep, voffB);
    PG8_WAIT_V(6); PG8_BAR;
    for (;;) {
        const bool has_next = S.next(ui + 1, nxt);
        const char* nA = has_next ? (const char*)g.A + (size_t)nxt.pm * tstepA : cA; const char* nB = has_next ? (const char*)g.Bt + (size_t)nxt.pn * tstep : cB;
        for (int t = 0; t < nt; t += 2) {
            const bool last = (t == nt - 2);
            const char* a1 = cA + (size_t)(t + 1) * kstep;
            const char* a2 = last ? nA : cA + (size_t)(t + 2) * kstep; const char* b2 = last ? nB : cB + (size_t)(t + 2) * kstep;
            const char* a3 = a2 + kstep; const char* b3 = b2 + kstep;
            if (last && has_next) S.a_ready(nxt);
            if constexpr (mid_hook<Epi>::value) { if (t == Epi::MID_T) E.mid(acc, cur, wr, wc, fr, fq); }
            PG8_LDB(B0, 0, 0); PG8_LDB(B1, 0, 1); PG8_SCHED; PG8_LDA(At, 0, 0); PG8_STAGE(PG8_SA(1, 1), a1 + hstepA, voffA);
            PG8_WAIT_V(8); PG8_WAIT_L(0); PG8_BAR; PG8_MMA(0, 0, At, B0); PG8_MMA(0, 1, At, B1); PG8_BAR; PG8_SCHED;
            PG8_LDA(At, 0, 1); PG8_STAGE(PG8_SB(0, 0), b2, voffB); PG8_STAGE(PG8_SB(0, 1), b2 + hstep, voffB); PG8_STAGE(PG8_SA(0, 0), a2, voffA);
            PG8_WAIT_V(8); PG8_WAIT_L(0); PG8_BAR; PG8_MMA(1, 0, At, B0); PG8_MMA(1, 1, At, B1); PG8_BAR; PG8_SCHED;
            PG8_LDB(B0, 1, 0); PG8_LDB(B1, 1, 1); PG8_SCHED; PG8_LDA(At, 1, 0); PG8_STAGE(PG8_SA(0, 1), a2 + hstepA, voffA);
            PG8_WAIT_V(8); PG8_WAIT_L(0); PG8_BAR; PG8_MMA(0, 0, At, B0); PG8_MMA(0, 1, At, B1); PG8_BAR; PG8_SCHED;
            PG8_LDA(At, 1, 1); PG8_STAGE(PG8_SB(1, 0), b3, voffB); PG8_STAGE(PG8_SB(1, 1), b3 + hstep, voffB); PG8_STAGE(PG8_SA(1, 0), a3, voffA);
            PG8_WAIT_V(8); PG8_WAIT_L(0); PG8_BAR; PG8_MMA(1, 0, At, B0); PG8_MMA(1, 1, At, B1); PG8_BAR; PG8_SCHED;
        }
        if (wr == 0) PG8_BAR;
        E(acc, cur, wr, wc, fr, fq); S.done(cur);
        if (!has_next) break;
#pragma unroll
        for (int a = 0; a < 2; ++a)
#pragma unroll
            for (int b = 0; b < 2; ++b)
#pragma unroll
                for (int m = 0; m < 4; ++m)
#pragma unroll
                    for (int n = 0; n < 2; ++n) acc[a][b][m][n] = (f32x4){0.f, 0.f, 0.f, 0.f};
        cur = nxt; cA = nA; cB = nB; ++ui;
        if (wr == 1) PG8_BAR;
    }
    PG8_WAIT_V(0);
    PG8_BAR;
#undef PG8_SA
#undef PG8_SB
#undef PG8_STAGE
#undef PG8_LDA
#undef PG8_LDB
#undef PG8_MMA
#undef PG8_WAIT_V
#undef PG8_WAIT_L
#undef PG8_BAR
#undef PG8_SCHED
}
}

__device__ __forceinline__ int proj_src_col(int c) {
    if (c < 1280) return c;
    if (c < 5376) return c + 24;
    if (c < 5400) return 1280 + (c - 5376);
    return -1;
}
__device__ __forceinline__ int pair_dim(int c) { return (c >> 1) + 32 * (c & 1); }
struct MapIdent { __device__ __forceinline__ int operator()(int n) const { return n; } };
struct MapProj { __device__ __forceinline__ int operator()(int n) const {
    const bool roped = (n < 640) || (n >= 768 && n < 896) || (n >= 1024 && n < 1152);
    return proj_src_col(roped ? (n & ~63) + pair_dim(n & 63) : n); } };
struct Map128 { __device__ __forceinline__ int operator()(int n) const { return n < 128 ? n : -1; } };
struct RowPair { __device__ __forceinline__ int operator()(int k) const { return (k & ~63) + pair_dim(k & 63); } };
template <class Map, class RMap> __device__ __forceinline__ void prep_transpose(const float* src, int K, int ldsrc, bf16_t* dst, int Nrows, Map map, RMap rmap, float* tile) {
    const int tidx = fresh_tid();
    const int tid = tidx, r = tid >> 6, c = tid & 63, nkt = K >> 6, nit = nkt * (Nrows >> 6);
    for (int item = blockIdx.x; item < nit; item += gridDim.x) {
        const int nt = item / nkt, kt = item - nt * nkt, n0 = nt * 64, k0 = kt * 64; const int sc = map(n0 + c);
#pragma unroll
        for (int ps = 0; ps < 8; ++ps) { const int kk = ps * 8 + r; tile[kk * 65 + c] = sc >= 0 ? src[(size_t)rmap(k0 + kk) * ldsrc + sc] : 0.f; }
        __syncthreads();
#pragma unroll
        for (int ps = 0; ps < 8; ++ps) { const int nn = ps * 8 + r; dst[(size_t)(n0 + nn) * K + k0 + c] = f2bf(tile[c * 65 + nn]); }
        __syncthreads();
    }
}
__device__ __forceinline__ void ph_prep(const Params& p, float* sm) {
    const int tidx = fresh_tid();
    const int tid = tidx, gtid = blockIdx.x * blockDim.x + tidx, gsz = gridDim.x * blockDim.x;
    unsigned char* ws = p.ws;
    float* rc = (float*)(ws + WS_ROPEC); float* rs = (float*)(ws + WS_ROPES); float* lb = (float*)(ws + WS_LB); float* mod = (float*)(ws + WS_MOD);
    for (int i = gtid; i < 2048 * 32; i += gsz) {
        const int t = i >> 5, k = i & 31;
        const float inv = exp2f(-(float)k * (13.287712379549449f / 32.0f));
        const float ang = (float)t * inv;
        const double a = (double)ang; const double n = rint(a * 0.15915494309189535); const float r = (float)(a - n * 6.283185307179586);
        rc[i] = cosf(r); rs[i] = sinf(r);
    }
    for (int i = gtid; i < 512; i += gsz) { const float a = p.lb_logits[i], b = p.lb_logits[512 + i]; const float m = fmaxf(a, b); const float ea = expf(a - m), eb = expf(b - m); lb[i] = ea / (ea + eb); }
    if (blockIdx.x < 192) {
        float* cs = sm; float* red = sm + 16384;
        for (int i = tid; i < 16384; i += 512) { const float c = p.c[i]; cs[i] = c / (1.0f + expf(-c)); }
        __syncthreads();
        for (int item = blockIdx.x; item < 192; item += gridDim.x) {
            const int j0 = item * 32, kq = tid >> 5, jj = tid & 31;
            float acc[16];
#pragma unroll
            for (int b = 0; b < 16; ++b) acc[b] = 0.f;
            for (int kk = 0; kk < 64; ++kk) { const int k = kq * 64 + kk; const float w = p.w_ada[(size_t)k * 6144 + j0 + jj];
#pragma unroll
                for (int b = 0; b < 16; ++b) acc[b] += cs[b * 1024 + k] * w; }
#pragma unroll
            for (int b = 0; b < 16; ++b) red[(kq * 16 + b) * 32 + jj] = acc[b];
            __syncthreads();
            { const int b = tid >> 5; float sacc = 0.f;
#pragma unroll
              for (int q = 0; q < 16; ++q) sacc += red[(q * 16 + b) * 32 + jj];
              mod[b * 6144 + j0 + jj] = sacc + p.b_ada[j0 + jj]; }
            __syncthreads();
        }
    }
    __syncthreads();
    prep_transpose(p.w_in, 1024, IN_COLS, (bf16_t*)(ws + WS_WIN), NPROJ, MapProj(), MapIdent(), sm);
    prep_transpose(p.w_branch, 1024, 1024, (bf16_t*)(ws + WS_WB), 1024, MapIdent(), MapIdent(), sm);
    prep_transpose(p.w_out, 1024, 1024, (bf16_t*)(ws + WS_WOUT), 1024, MapIdent(), MapIdent(), sm);
    prep_transpose(p.w_ck1, 2048, 128, (bf16_t*)(ws + WS_W1TK), 256, Map128(), RowPair(), sm);
    prep_transpose(p.w_cv1, 2048, 128, (bf16_t*)(ws + WS_W1TV), 256, Map128(), MapIdent(), sm);
    for (int item = blockIdx.x; item < 256; item += gridDim.x) {
        const int which = item >> 7, j = item & 127; const float* pe = which ? p.cmp_pos_v : p.cmp_pos_k; const float* w1 = which ? p.w_cv1 : p.w_ck1;
        float a = 0.f;
#pragma unroll
        for (int q = 0; q < 4; ++q) { const int i = tid + 512 * q; a += pe[i] * w1[(size_t)i * 128 + j]; }
        a = wave_sum(a);
        __syncthreads();
        if ((tid & 63) == 0) sm[tid >> 6] = a;
        __syncthreads();
        if (tid == 0) ((float*)(ws + WS_C0))[item] = ((sm[0] + sm[1]) + (sm[2] + sm[3])) + ((sm[4] + sm[5]) + (sm[6] + sm[7]));
    }
    __syncthreads();
    {
        float* sk = sm; float* wq = sm + 128 * 129; bf16_t* dst = (bf16_t*)(ws + WS_WQ);
        for (int item = blockIdx.x; item < 256; item += gridDim.x) {
            const int hp = item >> 4, c0 = (item & 15) * 64, h = hp >> 1, pp = hp & 1;
            for (int i = tid; i < 128 * 128; i += 512) { const int k = i >> 7, d = i & 127; sk[k * 129 + d] = p.sub_keys[(((size_t)pp * 8 + h) * 128 + k) * 128 + d]; }
            for (int i = tid; i < 64 * 128; i += 512) { const int c = i >> 7, d = i & 127; wq[c * 129 + d] = p.w_peer_q[(size_t)(c0 + c) * 2048 + h * 256 + pp * 128 + d]; }
            __syncthreads();
            const int lane = tid & 63, kq = tid >> 6;
            float acc[16];
#pragma unroll
            for (int i = 0; i < 16; ++i) acc[i] = 0.f;
            for (int d = 0; d < 128; ++d) { const float w = wq[lane * 129 + d];
#pragma unroll
                for (int i = 0; i < 16; ++i) acc[i] += sk[(kq * 16 + i) * 129 + d] * w; }
#pragma unroll
            for (int i = 0; i < 16; ++i) dst[(size_t)(hp * 128 + kq * 16 + i) * 1024 + c0 + lane] = f2bf(acc[i]);
            __syncthreads();
        }
    }
    { const int wave = tid >> 6, lane = tid & 63;
      float4 nv0, nv1, nv2, nv3;
      { const int r0 = blockIdx.x * 8 + wave; const float4* s0 = (const float4*)(((r0 >> 14) ? p.peer_v : p.peer_u) + (size_t)(r0 & 16383) * 1024); nv0 = s0[lane]; nv1 = s0[lane + 64]; nv2 = s0[lane + 128]; nv3 = s0[lane + 192]; }
      for (int row = blockIdx.x * 8 + wave; row < 32768; row += gridDim.x * 8) {
        const int which = row >> 14, e = row & 16383;
        float4 v[4] = {nv0, nv1, nv2, nv3}; float amax = 0.f;
        { const int rn = row + gridDim.x * 8; if (rn < 32768) { const float4* s1 = (const float4*)(((rn >> 14) ? p.peer_v : p.peer_u) + (size_t)(rn & 16383) * 1024); nv0 = s1[lane]; nv1 = s1[lane + 64]; nv2 = s1[lane + 128]; nv3 = s1[lane + 192]; } }
#pragma unroll
        for (int i = 0; i < 4; ++i) amax = fmaxf(amax, fmaxf(fmaxf(fabsf(v[i].x), fabsf(v[i].y)), fmaxf(fabsf(v[i].z), fabsf(v[i].w))));
        amax = wave_max(amax);
        const float inv = amax > 0.f ? 127.0f / amax : 0.f; const int off = which ? 128 : 0;
        unsigned* dst = (unsigned*)(ws + (which ? WS_V : WS_U) + (size_t)e * 1024);
#pragma unroll
        for (int i = 0; i < 4; ++i) {
            const int q0 = (int)rintf(v[i].x * inv) + off, q1 = (int)rintf(v[i].y * inv) + off, q2 = (int)rintf(v[i].z * inv) + off, q3 = (int)rintf(v[i].w * inv) + off;
            const unsigned wq_ = (unsigned)(q0 & 255) | ((unsigned)(q1 & 255) << 8) | ((unsigned)(q2 & 255) << 16) | ((unsigned)(q3 & 255) << 24);
            if (which) { const int cw = lane + 64 * i;
                ((unsigned*)(ws + WS_V))[(size_t)(cw >> 5) * (16384 * 32) + (size_t)e * 32 + (cw & 31)] = wq_; }
            else dst[lane + 64 * i] = wq_; }
        if (lane == 0) { ((float*)(ws + (which ? WS_SV : WS_SU)))[e] = amax * (1.0f / 127.0f); ((float*)(ws + WS_SUV))[2 * e + which] = amax * (1.0f / 127.0f); }
      } }
}

template <bool BF16IN> __device__ __forceinline__ void ph_rmsnorm_mod(const void* xin, const float* g, const float* mod, int sh_off, int sc_off, bf16_t* out, unsigned* x8, float* sx) {
    const int tidx = fresh_tid();
    const int wave = tidx >> 6, lane = tidx & 63, wpb = blockDim.x >> 6;
    constexpr int D = 4;
    const int nw = gridDim.x * wpb, gw = blockIdx.x * wpb + wave;
    const int rpw = (NTOK + nw - 1) / nw, rbeg = gw * rpw, rend = min(rbeg + rpw, NTOK);
    if (rbeg >= rend) return;
    float4 nf[D][4]; uint2 nb[D][4];
#pragma unroll
    for (int k = 0; k < D; ++k) { const int r0 = min(rbeg + k, rend - 1);
#pragma unroll
      for (int i = 0; i < 4; ++i) { if (BF16IN) nb[k][i] = ((const uint2*)((const bf16_t*)xin + (size_t)r0 * 1024))[lane + 64 * i]; else nf[k][i] = ((const float4*)((const float*)xin + (size_t)r0 * 1024))[lane + 64 * i]; } }
    int bcur = -1; float4 ga[4], shv[4];
    for (int row0 = rbeg; row0 < rend; row0 += D) {
#pragma unroll
      for (int k = 0; k < D; ++k) {
        const bool live = row0 + k < rend; const int row = min(row0 + k, rend - 1);
        if ((row >> 11) != bcur) { bcur = row >> 11; const float* mb = mod + bcur * 6144;
#pragma unroll
            for (int i = 0; i < 4; ++i) { const int col = (lane + 64 * i) * 4; const float4 gg = *(const float4*)(g + col), sc = *(const float4*)(mb + sc_off + col); shv[i] = *(const float4*)(mb + sh_off + col);
                ga[i] = make_float4(gg.x * (1.0f + sc.x), gg.y * (1.0f + sc.y), gg.z * (1.0f + sc.z), gg.w * (1.0f + sc.w)); } }
        float4 v[4]; float ss = 0.f;
#pragma unroll
        for (int i = 0; i < 4; ++i) {
            if (BF16IN) v[i] = make_float4(__uint_as_float(nb[k][i].x << 16), __uint_as_float(nb[k][i].x & 0xffff0000u), __uint_as_float(nb[k][i].y << 16), __uint_as_float(nb[k][i].y & 0xffff0000u));
            else v[i] = nf[k][i];
            ss += v[i].x * v[i].x + v[i].y * v[i].y + v[i].z * v[i].z + v[i].w * v[i].w; }
        { const int rn = min(row + D, rend - 1);
#pragma unroll
          for (int i = 0; i < 4; ++i) { if (BF16IN) nb[k][i] = ((const uint2*)((const bf16_t*)xin + (size_t)rn * 1024))[lane + 64 * i]; else nf[k][i] = ((const float4*)((const float*)xin + (size_t)rn * 1024))[lane + 64 * i]; } }
        ss = wave_sum(ss);
        const float rstd = rsqrtf(ss * (1.0f / 1024.0f) + 1e-6f);
#pragma unroll
        for (int i = 0; i < 4; ++i) {
            const int col = (lane + 64 * i) * 4;
            const float o0 = v[i].x * rstd * ga[i].x + shv[i].x, o1 = v[i].y * rstd * ga[i].y + shv[i].y;
            const float o2 = v[i].z * rstd * ga[i].z + shv[i].z, o3 = v[i].w * rstd * ga[i].w + shv[i].w;
            if (live) *(uint2*)(out + (size_t)row * 1024 + col) = make_uint2(pack2bf(o0, o1), pack2bf(o2, o3));
            v[i] = make_float4(o0, o1, o2, o3);
        }
        if (x8 && live) {
            float amax = 0.f;
#pragma unroll
            for (int i = 0; i < 4; ++i) amax = fmaxf(amax, fmaxf(fmaxf(fabsf(v[i].x), fabsf(v[i].y)), fmaxf(fabsf(v[i].z), fabsf(v[i].w))));
            amax = wave_max(amax); const float inv = amax > 0.f ? 127.0f / amax : 0.f;
#pragma unroll
            for (int i = 0; i < 4; ++i) { const int q0 = (int)rintf(v[i].x * inv), q1 = (int)rintf(v[i].y * inv), q2 = (int)rintf(v[i].z * inv), q3 = (int)rintf(v[i].w * inv);
                x8[(size_t)row * 256 + lane + 64 * i] = (unsigned)(q0 & 255) | ((unsigned)(q1 & 255) << 8) | ((unsigned)(q2 & 255) << 16) | ((unsigned)(q3 & 255) << 24); }
            if (lane == 0) sx[row] = amax * (1.0f / 127.0f);
        }
      }
    }
}

__device__ __forceinline__ void compress_stage2(const bf16_t* HID, const float* w2, bf16_t* dst, int pm, bool pairperm, float* w2s) {
    typedef short bf16x8_ __attribute__((ext_vector_type(8))); typedef float f32x4_ __attribute__((ext_vector_type(4)));
    const int tidx = fresh_tid();
    const int lane = tidx & 63, l15 = lane & 15, g = lane >> 4, wid = tidx >> 6;
    bf16_t* w2t = (bf16_t*)w2s;
    __syncthreads();
    for (int i = tidx; i < 128 * 64; i += 512) { const int j = i >> 6, c = i & 63; w2t[c * 136 + j] = f2bf(w2[j * 64 + (pairperm ? pair_dim(c) : c)]); }
    asm volatile("s_waitcnt vmcnt(0)" ::: "memory");
    __syncthreads();
    f32x4_ acc[2][4];
#pragma unroll
    for (int mt = 0; mt < 2; ++mt)
#pragma unroll
        for (int nt = 0; nt < 4; ++nt) acc[mt][nt] = (f32x4_){0.f, 0.f, 0.f, 0.f};
    const int row0 = pm * 256 + wid * 32;
#pragma unroll
    for (int ks = 0; ks < 4; ++ks) {
        bf16x8_ af[2], bfr[4];
#pragma unroll
        for (int mt = 0; mt < 2; ++mt) af[mt] = *(const bf16x8_*)(HID + (size_t)(row0 + 16 * mt + l15) * 128 + 32 * ks + 8 * g);
#pragma unroll
        for (int nt = 0; nt < 4; ++nt) bfr[nt] = *(const bf16x8_*)(w2t + (16 * nt + l15) * 136 + 32 * ks + 8 * g);
#pragma unroll
        for (int mt = 0; mt < 2; ++mt)
#pragma unroll
            for (int nt = 0; nt < 4; ++nt) acc[mt][nt] = __builtin_amdgcn_mfma_f32_16x16x32_bf16(af[mt], bfr[nt], acc[mt][nt], 0, 0, 0);
    }
#pragma unroll
    for (int mt = 0; mt < 2; ++mt)
#pragma unroll
        for (int r = 0; r < 4; ++r) { const int row = row0 + 16 * mt + 4 * g + r; const bool pad = (row & 127) == 127;
#pragma unroll
            for (int nt = 0; nt < 4; ++nt) dst[(size_t)row * 64 + 16 * nt + l15] = pad ? (bf16_t)0 : f2bf(acc[mt][nt][r]); }
}

namespace att {
typedef short bf16x8 __attribute__((ext_vector_type(8)));
typedef short s16x4 __attribute__((ext_vector_type(4)));
typedef float f32x16 __attribute__((ext_vector_type(16)));
typedef float f32x2_t __attribute__((ext_vector_type(2))); typedef __bf16 bf16x2_t __attribute__((ext_vector_type(2)));
typedef const LAS char* lds_cptr;
constexpr float C2 = 0.125f * 1.4426950408889634f;
__device__ __forceinline__ int crow(int r, int hi) { return (r & 3) + 8 * (r >> 2) + 4 * hi; }
__device__ __forceinline__ unsigned cvtpk(float lo, float hi) { f32x2_t v = {lo, hi}; bf16x2_t b = __builtin_convertvector(v, bf16x2_t); return __builtin_bit_cast(unsigned, b); }
typedef unsigned u32x4v __attribute__((ext_vector_type(4)));
struct TileRegs { u32x4v k, v; };
__device__ __forceinline__ TileRegs tile_fetch(const bf16_t* kb, int kpitch, const bf16_t* vb, int vpitch, int wid, int lane) {
    TileRegs t; t.k = *(const u32x4v*)(kb + (size_t)lane * kpitch + wid * 8);
    t.v = *(const u32x4v*)(vb + (size_t)(16 * (wid & 3) + (lane >> 2)) * vpitch + (wid >> 2) * 32 + (lane & 3) * 8); return t; }
__device__ __forceinline__ void tile_dma(LAS char* kbuf, LAS char* vbuf, const bf16_t* kb, int kpitch, const bf16_t* vb, int vpitch, int wid, int lane) {
    __builtin_amdgcn_global_load_lds((const unsigned*)(kb + (size_t)lane * kpitch + wid * 8), (LAS unsigned*)(kbuf + wid * 1024), 16, 0, 0);
    __builtin_amdgcn_global_load_lds((const unsigned*)(vb + (size_t)(16 * (wid & 3) + (lane >> 2)) * vpitch + (wid >> 2) * 32 + (lane & 3) * 8), (LAS unsigned*)(vbuf + wid * 1024), 16, 0, 0);
}
__device__ __forceinline__ void tile_store(LAS char* kbuf, LAS char* vbuf, const TileRegs& t, int wid, int lane) {
    *(LAS u32x4v*)(kbuf + wid * 1024 + lane * 16) = t.k; *(LAS u32x4v*)(vbuf + wid * 1024 + lane * 16) = t.v; }
__device__ __forceinline__ void qk_tile(f32x16& p0, f32x16& p1, lds_cptr kp, lds_cptr qp) {
    f32x16 z;
#pragma unroll
    for (int r = 0; r < 16; ++r) z[r] = 0.f;
    p0 = z; p1 = z;
#pragma unroll
    for (int d0 = 0; d0 < 4; ++d0) {
        const bf16x8 b0 = *(const LAS bf16x8*)(kp + d0 * 2048), b1 = *(const LAS bf16x8*)(kp + d0 * 2048 + 512), q = *(const LAS bf16x8*)(qp + d0 * 1024);
        p0 = __builtin_amdgcn_mfma_f32_32x32x16_bf16(b0, q, p0, 0, 0, 0); p1 = __builtin_amdgcn_mfma_f32_32x32x16_bf16(b1, q, p1, 0, 0, 0); }
}
__device__ __forceinline__ s16x4 vtr(lds_cptr p) { typedef short v4i16_t __attribute__((ext_vector_type(4))); return __builtin_bit_cast(s16x4, __builtin_amdgcn_ds_read_tr16_b64_v4i16((LAS v4i16_t*)p)); }
__device__ __forceinline__ void pv_tile(f32x16& o0, f32x16& o1, lds_cptr vp, const f32x16& p0, const f32x16& p1) {
    bf16x8 pa[4];
    { typedef unsigned u32x4_t __attribute__((ext_vector_type(4)));
      u32x4_t w0 = {cvtpk(p0[0], p0[1]), cvtpk(p0[2], p0[3]), cvtpk(p0[4], p0[5]), cvtpk(p0[6], p0[7])}; u32x4_t w1 = {cvtpk(p0[8], p0[9]), cvtpk(p0[10], p0[11]), cvtpk(p0[12], p0[13]), cvtpk(p0[14], p0[15])};
      u32x4_t w2 = {cvtpk(p1[0], p1[1]), cvtpk(p1[2], p1[3]), cvtpk(p1[4], p1[5]), cvtpk(p1[6], p1[7])}; u32x4_t w3 = {cvtpk(p1[8], p1[9]), cvtpk(p1[10], p1[11]), cvtpk(p1[12], p1[13]), cvtpk(p1[14], p1[15])};
      pa[0] = __builtin_bit_cast(bf16x8, w0); pa[1] = __builtin_bit_cast(bf16x8, w1); pa[2] = __builtin_bit_cast(bf16x8, w2); pa[3] = __builtin_bit_cast(bf16x8, w3); }
#pragma unroll
    for (int ks = 0; ks < 4; ++ks) {
        const s16x4 l0 = vtr(vp + ks * 1024), h0 = vtr(vp + ks * 1024 + 512), l1 = vtr(vp + 4096 + ks * 1024), h1 = vtr(vp + 4096 + ks * 1024 + 512);
        const bf16x8 v0 = {l0[0], l0[1], l0[2], l0[3], h0[0], h0[1], h0[2], h0[3]}, v1 = {l1[0], l1[1], l1[2], l1[3], h1[0], h1[1], h1[2], h1[3]};
        o0 = __builtin_amdgcn_mfma_f32_32x32x16_bf16(pa[ks], v0, o0, 0, 0, 0); o1 = __builtin_amdgcn_mfma_f32_32x32x16_bf16(pa[ks], v1, o1, 0, 0, 0); }
}
__device__ __forceinline__ float max3f(float a, float b, float c) { return fmaxf(fmaxf(a, b), c); }
__device__ __forceinline__ void softmax_step(f32x16& p0, f32x16& p1, float bias, bool need_mask, int key0, int t, int lo, int hi, int r32, float& mhat, float& lsum, f32x16& o0, f32x16& o1, LAS float* wsf) {
    if (need_mask) {
        asm volatile("" ::: "memory");
#pragma unroll
        for (int r = 0; r < 16; ++r) { const int k = key0 + crow(r, hi); if (!(k <= t && k >= lo)) p0[r] = -INFINITY; if (!(k + 32 <= t && k + 32 >= lo)) p1[r] = -INFINITY; }
    }
    float ra = max3f(p0[0], p0[1], p1[0]), rb = max3f(p0[2], p0[3], p1[1]); ra = max3f(ra, p1[2], p1[3]);
#pragma unroll
    for (int r = 4; r < 16; r += 4) { ra = max3f(ra, p0[r], p0[r + 1]); rb = max3f(rb, p0[r + 2], p0[r + 3]); ra = max3f(ra, p1[r], p1[r + 1]); rb = max3f(rb, p1[r + 2], p1[r + 3]); }
    float rm = half_max(fmaxf(ra, rb));
    rm = fmaf(rm, C2, bias);
    if (__any(rm > mhat + 8.0f)) {
        const float mnew = fmaxf(mhat, rm); const float f = __builtin_amdgcn_exp2f(mhat - mnew); lsum *= f; mhat = mnew;
        if (hi == 0) wsf[r32] = f;
        wave_lds_sync();
#pragma unroll
        for (int r = 0; r < 16; ++r) { const float fr = wsf[crow(r, hi)]; o0[r] *= fr; o1[r] *= fr; }
        wave_lds_sync();
    }
    const float nb = bias - mhat; float sacc = 0.f;
#pragma unroll
    for (int r = 0; r < 16; ++r) { p0[r] = __builtin_amdgcn_exp2f(fmaf(p0[r], C2, nb)); p1[r] = __builtin_amdgcn_exp2f(fmaf(p1[r], C2, nb)); sacc += p0[r] + p1[r]; }
    lsum += sacc;
}
template <bool ADD> __device__ __forceinline__ void add_scaled(LAS float* OT, const f32x16& o0, const f32x16& o1, float fac, int hi, int r32, LAS float* wsf) {
    wave_lds_sync();
    if (hi == 0) wsf[32 + r32] = fac;
    wave_lds_sync();
#pragma unroll
    for (int r = 0; r < 16; ++r) { const float fr = wsf[32 + crow(r, hi)]; LAS float* q = OT + crow(r, hi) * 64 + r32;
        if (ADD) { q[0] += o0[r] * fr; q[32] += o1[r] * fr; } else { q[0] = o0[r] * fr; q[32] = o1[r] * fr; } }
    wave_lds_sync();
}
__device__ __forceinline__ float imp_sum(const LAS float* IMP, const LAS float* INV, int tk, int i) {
    return ((IMP[(0 * 64 + tk) * 33 + i] * INV[tk] + IMP[(1 * 64 + tk) * 33 + i] * INV[64 + tk]) + IMP[(2 * 64 + tk) * 33 + i] * INV[128 + tk]) + IMP[(3 * 64 + tk) * 33 + i] * INV[192 + tk]; }

__device__ __forceinline__ void glds16(const void* sbase, unsigned voff, unsigned lds_dst) { unsigned keep;
    asm volatile("s_mov_b32 %0, m0\n\ts_mov_b32 m0, %3\n\ts_nop 0\n\tglobal_load_lds_dwordx4 %1, %2\n\ts_mov_b32 m0, %0" : "=&s"(keep) : "v"(voff), "s"(sbase), "s"(lds_dst) : "memory"); }
__device__ __forceinline__ void kload8(bf16x8* kf, lds_cptr kp) {
    kf[0] = *(const LAS bf16x8*)(kp);        kf[1] = *(const LAS bf16x8*)(kp + 512);  kf[2] = *(const LAS bf16x8*)(kp + 2048); kf[3] = *(const LAS bf16x8*)(kp + 2560);
    kf[4] = *(const LAS bf16x8*)(kp + 4096); kf[5] = *(const LAS bf16x8*)(kp + 4608); kf[6] = *(const LAS bf16x8*)(kp + 6144); kf[7] = *(const LAS bf16x8*)(kp + 6656); }
__device__ __forceinline__ void kload2(bf16x8* kf, lds_cptr kp, int j) { kf[2 * j] = *(const LAS bf16x8*)(kp + j * 2048); kf[2 * j + 1] = *(const LAS bf16x8*)(kp + j * 2048 + 512); }
__device__ __forceinline__ float swapmax(float m) { auto rr = __builtin_amdgcn_permlane32_swap(__float_as_uint(m), __float_as_uint(m), false, false); return fmaxf(__uint_as_float(rr[0]), __uint_as_float(rr[1])); }
}

__device__ __forceinline__ void ph_attn(const Params& p, unsigned char* smem, unsigned* qctr) {
    using namespace att;
    const int tidx = fresh_tid();
    const bf16_t* PA = (const bf16_t*)(p.ws + WS_PA); const bf16_t* PG = (const bf16_t*)(p.ws + WS_PG);
    const bf16_t* KCB = (const bf16_t*)(p.ws + WS_KCMP); const bf16_t* VCB = (const bf16_t*)(p.ws + WS_VCMP);
    bf16_t* onsa = (bf16_t*)(p.ws + WS_HBF);
    LAS char* lds = (LAS char*)smem;
    LAS float* IMP = (LAS float*)(lds + 67584);
    LAS unsigned* SEL = (LAS unsigned*)(lds + 133120); LAS float* INV = (LAS float*)(lds + 133120 + 256);
    volatile LAS int* qslot = (volatile LAS int*)(lds + (144 * 1024 - 32));
    unsigned nxt = 0;
    if (tidx == 0) nxt = __hip_atomic_fetch_add(qctr, 1u, __ATOMIC_RELAXED, __HIP_MEMORY_SCOPE_AGENT);
    for (;;) {
      __syncthreads();
      if (tidx == 0) *qslot = (int)nxt;
      __syncthreads();
      const int qi = __builtin_amdgcn_readfirstlane(*qslot);
      if (qi >= 1024) break;
      if (tidx == 0) nxt = __hip_atomic_fetch_add(qctr, 1u, __ATOMIC_RELAXED, __HIP_MEMORY_SCOPE_AGENT);
      const int qt = 31 - (qi >> 5), bg = qi & 31, b = bg >> 1, g = bg & 1;
      const bf16_t* PAb = PA + (size_t)b * 2048 * 1280;
      const int tid = fresh_tid(); const int lane = tid & 63, r32 = lane & 31, hi = lane >> 5, wid = __builtin_amdgcn_readfirstlane(tid >> 6);
      LAS char* KB[2] = {lds, lds + 8192}; LAS char* VB[2] = {lds + 16384, lds + 24576};
      LAS float* wsf = (LAS float*)(lds + 32768) + wid * 64;
      LAS char* QL = lds + 34816 + wid * 4096;
      LAS float* OT = (LAS float*)(lds + 67584) + wid * 2048;
      const int kfo = hi * 1024 + r32 * 16;
      const int vfo = ((lane >> 4) & 1) * 32 + (lane & 3) * 8 + (4 * hi + ((lane & 15) >> 2)) * 64;
      lds_cptr qp = QL + hi * 512 + r32 * 16;
      {
        const int th = wid >> 2, rh = wid & 3, h = 4 * g + rh, tloc = 32 * th + r32, t = 64 * qt + tloc; const size_t tok = (size_t)b * 2048 + t;
#pragma unroll
        for (int d0 = 0; d0 < 4; ++d0) *(LAS u32x4v*)(QL + hi * 512 + r32 * 16 + d0 * 1024) = *(const u32x4v*)(PA + tok * 1280 + h * 64 + 16 * d0 + 8 * hi);
        const bf16_t gl0 = PG[tok * 256 + h * 3], gl1 = PG[tok * 256 + h * 3 + 1], gl2 = PG[tok * 256 + h * 3 + 2];
        LAS float* GATE = (LAS float*)(lds + 142848);
        f32x16 o0, o1, pA0, pA1;
        float cinv;
        {
            const bf16_t* kc = KCB + (size_t)(b * 2 + g) * 128 * 64; const bf16_t* vc = VCB + (size_t)(b * 2 + g) * 128 * 64;
            tile_dma(KB[0], VB[0], kc, 64, vc, 64, wid, lane); tile_dma(KB[1], VB[1], kc + 64 * 64, 64, vc + 64 * 64, 64, wid, lane);
            if (hi == 0) { GATE[(wid * 3 + 0) * 32 + r32] = sigmoidf_(bf2f(gl0)); GATE[(wid * 3 + 1) * 32 + r32] = sigmoidf_(bf2f(gl1)); GATE[(wid * 3 + 2) * 32 + r32] = sigmoidf_(bf2f(gl2)); }
            __syncthreads();
            const int nv = (t >= 31) ? ((t - 31) >> 4) + 1 : 0;
            float rm = -INFINITY;
#pragma unroll
            for (int ct = 0; ct < 2; ++ct) {
                qk_tile(pA0, pA1, KB[ct] + kfo, qp);
#pragma unroll
                for (int r = 0; r < 16; ++r) { const int n = 64 * ct + crow(r, hi); rm = fmaxf(rm, fmaxf((n < nv) ? pA0[r] : -INFINITY, (n + 32 < nv) ? pA1[r] : -INFINITY)); }
            }
            rm = half_max(rm); const float mref = (rm > -INFINITY) ? rm * C2 : 0.f;
            float ls = 0.f, a7 = 0.f;
#pragma unroll
            for (int r = 0; r < 16; ++r) { o0[r] = 0.f; o1[r] = 0.f; }
#pragma unroll
            for (int ct = 0; ct < 2; ++ct) {
                qk_tile(pA0, pA1, KB[ct] + kfo, qp);
#pragma unroll
                for (int r = 0; r < 16; ++r) { const int n = 64 * ct + crow(r, hi);
                    pA0[r] = (n < nv) ? __builtin_amdgcn_exp2f(fmaf(pA0[r], C2, -mref)) : 0.f; pA1[r] = (n + 32 < nv) ? __builtin_amdgcn_exp2f(fmaf(pA1[r], C2, -mref)) : 0.f; ls += pA0[r] + pA1[r]; }
                if (qt >= 16) {
                    float F[8], A[8], PF[8];
#pragma unroll
                    for (int gq = 0; gq < 4; ++gq) {
                        F[gq] = pA0[4 * gq]; A[gq] = pA0[4 * gq] + 2.0f * ((pA0[4 * gq + 1] + pA0[4 * gq + 2]) + pA0[4 * gq + 3]);
                        F[4 + gq] = pA1[4 * gq]; A[4 + gq] = pA1[4 * gq] + 2.0f * ((pA1[4 * gq + 1] + pA1[4 * gq + 2]) + pA1[4 * gq + 3]); }
#pragma unroll
                    for (int q = 0; q < 8; ++q) PF[q] = half_other(F[q]);
                    LAS float* dst = IMP + (rh * 64 + tloc) * 33 + 16 * ct + hi;
                    const unsigned himask = 0u - (unsigned)hi;
#pragma unroll
                    for (int q = 0; q < 7; ++q) dst[2 * q] = A[q] + __uint_as_float((__float_as_uint(PF[q]) & ~himask) | (__float_as_uint(PF[q + 1]) & himask));
                    if (ct == 0) { if (hi == 0) dst[14] = A[7] + PF[7]; else { a7 = A[7]; } }
                    else { if (hi) { dst[14 - 16] = a7 + PF[0]; dst[14] = A[7]; } else dst[14] = A[7] + PF[7]; }
                }
                pv_tile(o0, o1, VB[ct] + vfo, pA0, pA1);
            }
            ls = half_sum(ls); cinv = ls > 0.f ? 1.0f / ls : 0.f;
        }
        unsigned selmask;
        if (qt >= 16) {
            const int tid2 = fresh_tid(); const int lane2 = tid2 & 63, wid2 = tid2 >> 6, tloc2 = 32 * (wid2 >> 2) + (lane2 & 31);
            if (lane2 < 32) INV[(wid2 & 3) * 64 + tloc2] = cinv;
            __syncthreads();
            { const int tk = tid2 >> 3, jg = tid2 & 7;
              LAS float* VAL = (LAS float*)(lds + 134400);
#pragma unroll
              for (int jj = 0; jj < 4; ++jj) { const int j = 4 * jg + jj; const float v = imp_sum(IMP, INV, tk, j); const bool forced = (j == 0) || (j == qt) || (j == qt - 1);
                  VAL[tk * 33 + j] = (j <= qt) ? v + (forced ? 1000.f : 0.f) : -1.0f; }
              __syncthreads();
              float vj[4]; int rank[4] = {0, 0, 0, 0};
#pragma unroll
              for (int jj = 0; jj < 4; ++jj) vj[jj] = VAL[tk * 33 + 4 * jg + jj];
#pragma unroll 4
              for (int i = 0; i < 32; ++i) { const float vi = VAL[tk * 33 + i];
#pragma unroll
                  for (int jj = 0; jj < 4; ++jj) rank[jj] += ((vi > vj[jj]) || (vi == vj[jj] && i < 4 * jg + jj)) ? 1 : 0; }
              unsigned bits = 0;
#pragma unroll
              for (int jj = 0; jj < 4; ++jj) if (rank[jj] < 16 && 4 * jg + jj <= qt) bits |= 1u << (4 * jg + jj);
              bits |= xor_getu<1>(bits); bits |= xor_getu<2>(bits); bits |= xor_getu<4>(bits);
              if (jg == 0) SEL[tk] = bits; }
            __syncthreads();
            selmask = SEL[tloc2];
        } else selmask = (2u << qt) - 1u;
        add_scaled<false>(OT, o0, o1, GATE[(wid * 3) * 32 + r32] * cinv, hi, r32, wsf);
#pragma unroll 1
        for (int br = 1; br < 3; ++br) {
            const int j0 = (br == 1) ? 0 : (qt > 8 ? qt - 8 : 0);
            const int koff = (br == 1 ? 768 : 1024) + g * 64, voff = (br == 1 ? 896 : 1152) + g * 64;
            const int lo = (br == 1) ? -(1 << 30) : t - 511;
            float mhat = -1e30f, lsum = 0.f;
#pragma unroll
            for (int r = 0; r < 16; ++r) { o0[r] = 0.f; o1[r] = 0.f; }
            const unsigned kvo = (unsigned)(lane * 2560 + wid * 16), vvo = (unsigned)((16 * (wid & 3) + (lane >> 2)) * 2560 + (wid >> 2) * 64 + (lane & 3) * 16);
            const unsigned lds0 = (unsigned)(uintptr_t)lds;
#define DMA_K(tt) glds16(PAb + koff + (size_t)(tt) * (64 * 1280), kvo, (unsigned)__builtin_amdgcn_readfirstlane(lds0 + wid * 1024 + (((tt) & 1) << 13)))
#define DMA_V(tt) glds16(PAb + voff + (size_t)(tt) * (64 * 1280), vvo, (unsigned)__builtin_amdgcn_readfirstlane(lds0 + 16384 + wid * 1024 + (((tt) & 1) << 13)))
#define WAIT_BAR() asm volatile("s_waitcnt vmcnt(0) lgkmcnt(0)\n\ts_barrier" ::: "memory")
#define SBAR() __builtin_amdgcn_sched_barrier(0)
#define MFMA32(a, b, c) __builtin_amdgcn_mfma_f32_32x32x16_bf16(a, b, c, 0, 0, 0)
            __syncthreads();
            DMA_K(j0); DMA_V(j0);
            WAIT_BAR();
            f32x16 pB0, pB1; bool resc = false;
            if (j0 < qt) DMA_K(j0 + 1);
            qk_tile(pA0, pA1, lds + ((j0 & 1) << 13) + kfo, qp);
#define MASKT(C0, C1, tt) do { if (((tt) == qt) || (br == 2 && (tt) == qt - 8)) { asm volatile("" ::: "memory"); \
                _Pragma("unroll") for (int r = 0; r < 16; ++r) { const int k_ = 64 * (tt) + crow(r, hi); if (!(k_ <= t && k_ >= lo)) C0[r] = -INFINITY; if (!(k_ + 32 <= t && k_ + 32 >= lo)) C1[r] = -INFINITY; } } } while (0)
#define DECIDE(C0, C1, tt) \
                const float bias_ = (br == 1 && !((selmask >> (tt)) & 1u)) ? -INFINITY : 0.f; \
                { float a_ = max3f(C0[0], C0[1], C1[0]), b_ = max3f(C0[2], C0[3], C1[1]); a_ = max3f(a_, C1[2], C1[3]); \
                  _Pragma("unroll") for (int r = 4; r < 16; r += 4) { a_ = max3f(a_, C0[r], C0[r + 1]); b_ = max3f(b_, C0[r + 2], C0[r + 3]); a_ = max3f(a_, C1[r], C1[r + 1]); b_ = max3f(b_, C1[r + 2], C1[r + 3]); } \
                  float rm_ = swapmax(fmaxf(a_, b_)); rm_ = fmaf(rm_, C2, bias_); resc = false; \
                  if (__any(rm_ > mhat + 8.0f)) { const float mnew_ = fmaxf(mhat, rm_); const float f_ = __builtin_amdgcn_exp2f(mhat - mnew_); lsum *= f_; mhat = mnew_; if (hi == 0) wsf[r32] = f_; resc = true; } } \
                const float nb_ = bias_ - mhat;
            { MASKT(pA0, pA1, j0); DECIDE(pA0, pA1, j0)
#pragma unroll
              for (int r = 0; r < 16; ++r) { pA0[r] = __builtin_amdgcn_exp2f(fmaf(pA0[r], C2, nb_)); pA1[r] = __builtin_amdgcn_exp2f(fmaf(pA1[r], C2, nb_)); } }
            WAIT_BAR();
            s16x4 vlo[8], vhi[8]; u32x4v pw0, pw1, pw2, pw3;
#define PKW(P, B) cvtpk(P[B], P[(B) + 1])
#define PAF(k) __builtin_bit_cast(bf16x8, pw##k)
#define VFR(i) (bf16x8){vlo[i][0], vlo[i][1], vlo[i][2], vlo[i][3], vhi[i][0], vhi[i][1], vhi[i][2], vhi[i][3]}
#define PIN(x) asm volatile("" : "+v"(x))
#define GAPA(MF, A0, A1, A2, A3, W0, W1, PW) do { MF; sacc += A0; sacc += A1; sacc += A2; sacc += A3; PIN(sacc); W0; W1; PIN(PW); SBAR(); } while (0)
#define EXF(v) __builtin_amdgcn_exp2f(fmaf(v, C2, nb_))
#define GAPB(MF, X, B) do { MF; X[B] = EXF(X[B]); X[(B) + 1] = EXF(X[(B) + 1]); X[(B) + 2] = EXF(X[(B) + 2]); X[(B) + 3] = EXF(X[(B) + 3]); PIN(X); SBAR(); } while (0)
#define VRD(i) do { vlo[i] = vtr(vp_ + (((i) >> 2) * 4096 + ((i) & 3) * 1024)); vhi[i] = vtr(vp_ + (((i) >> 2) * 4096 + ((i) & 3) * 1024 + 512)); } while (0)
#define KFR(i) (*(const LAS bf16x8*)(kp_ + ((i) >> 1) * 2048 + ((i) & 1) * 512))
#define STEP(C0, C1, P0, P1, tt) do { SBAR(); \
                const lds_cptr vp_ = lds + 16384 + ((((tt) - 1) & 1) << 13) + vfo; const lds_cptr kp_ = lds + (((tt) & 1) << 13) + kfo; \
                const f32x16 z16 = {0.f, 0.f, 0.f, 0.f, 0.f, 0.f, 0.f, 0.f, 0.f, 0.f, 0.f, 0.f, 0.f, 0.f, 0.f, 0.f}; \
                bf16x8 q_ = *(const LAS bf16x8*)(qp), ka_ = KFR(0), kb_; \
                VRD(0); kb_ = KFR(1); SBAR(); float sacc = (P0[0] + P0[1]); \
                GAPA(C0 = MFMA32(ka_, q_, z16), P0[2], P0[3], P0[4], P0[5],     pw0[0] = PKW(P0, 0),  pw0[1] = PKW(P0, 2),  pw0); \
                VRD(4); ka_ = KFR(2); SBAR(); GAPA(C1 = MFMA32(kb_, q_, z16), P0[6], P0[7], P0[8], P0[9],     pw0[2] = PKW(P0, 4),  pw0[3] = PKW(P0, 6),  pw0); \
                q_ = *(const LAS bf16x8*)(qp + 1024); \
                kb_ = KFR(3); SBAR(); GAPA(C0 = MFMA32(ka_, q_, C0),  P0[10], P0[11], P0[12], P0[13], pw1[0] = PKW(P0, 8),  pw1[1] = PKW(P0, 10), pw1); \
                ka_ = KFR(4); SBAR(); GAPA(C1 = MFMA32(kb_, q_, C1),  P0[14], P0[15], P1[0], P1[1],   pw1[2] = PKW(P0, 12), pw1[3] = PKW(P0, 14), pw1); \
                q_ = *(const LAS bf16x8*)(qp + 2048); \
                kb_ = KFR(5); SBAR(); GAPA(C0 = MFMA32(ka_, q_, C0),  P1[2], P1[3], P1[4], P1[5],     pw2[0] = PKW(P1, 0),  pw2[1] = PKW(P1, 2),  pw2); \
                ka_ = KFR(6); SBAR(); GAPA(C1 = MFMA32(kb_, q_, C1),  P1[6], P1[7], P1[8], P1[9],     pw2[2] = PKW(P1, 4),  pw2[3] = PKW(P1, 6),  pw2); \
                q_ = *(const LAS bf16x8*)(qp + 3072); \
                kb_ = KFR(7); SBAR(); GAPA(C0 = MFMA32(ka_, q_, C0),  P1[10], P1[11], P1[12], P1[13], pw3[0] = PKW(P1, 8),  pw3[1] = PKW(P1, 10), pw3); \
                SBAR(); GAPA(C1 = MFMA32(kb_, q_, C1),  P1[14], P1[15], 0.f, 0.f,       pw3[2] = PKW(P1, 12), pw3[3] = PKW(P1, 14), pw3); \
                lsum += sacc; \
                if ((tt) + 1 <= qt) DMA_K((tt) + 1); DMA_V(tt); \
                MASKT(C0, C1, tt); DECIDE(C0, C1, tt) \
                SBAR(); \
                VRD(1); SBAR(); GAPB(o0 = MFMA32(PAF(0), VFR(0), o0), C0, 0); \
                VRD(5); SBAR(); GAPB(o1 = MFMA32(PAF(0), VFR(4), o1), C0, 4); \
                VRD(2); SBAR(); GAPB(o0 = MFMA32(PAF(1), VFR(1), o0), C0, 8); \
                VRD(6); SBAR(); GAPB(o1 = MFMA32(PAF(1), VFR(5), o1), C0, 12); \
                VRD(3); SBAR(); GAPB(o0 = MFMA32(PAF(2), VFR(2), o0), C1, 0); \
                VRD(7); SBAR(); GAPB(o1 = MFMA32(PAF(2), VFR(6), o1), C1, 4); \
                GAPB(o0 = MFMA32(PAF(3), VFR(3), o0), C1, 8); \
                GAPB(o1 = MFMA32(PAF(3), VFR(7), o1), C1, 12); \
                WAIT_BAR(); \
                if (resc) { _Pragma("unroll") for (int r = 0; r < 16; ++r) { const float fr_ = wsf[crow(r, hi)]; o0[r] *= fr_; o1[r] *= fr_; } wave_lds_sync(); } \
            } while (0)
#define DRAIN(P0, P1) do { float sacc = 0.f; _Pragma("unroll") for (int r = 0; r < 16; ++r) sacc += P0[r] + P1[r]; lsum += sacc; pv_tile(o0, o1, lds + 16384 + ((qt & 1) << 13) + vfo, P0, P1); } while (0)
            { int tt = j0 + 1;
              for (; tt + 1 <= qt; tt += 2) { STEP(pB0, pB1, pA0, pA1, tt); STEP(pA0, pA1, pB0, pB1, tt + 1); }
              if (tt <= qt) { STEP(pB0, pB1, pA0, pA1, tt); DRAIN(pB0, pB1); } else { DRAIN(pA0, pA1); } }
#undef DMA_K
#undef DMA_V
#undef WAIT_BAR
#undef MASKT
#undef DECIDE
#undef PKW
#undef PAF
#undef VFR
#undef PIN
#undef GAPA
#undef EXF
#undef GAPB
#undef VRD
#undef KFR
#undef STEP
#undef DRAIN
#undef MFMA32
#undef SBAR
            lsum = half_sum(lsum);
            { const int tid3 = fresh_tid(); const int lane3 = tid3 & 63, r323 = lane3 & 31, hi3 = lane3 >> 5, wid3 = __builtin_amdgcn_readfirstlane(tid3 >> 6);
              add_scaled<true>((LAS float*)(lds + 67584) + wid3 * 2048, o0, o1, lsum > 0.f ? ((const LAS float*)(lds + 142848))[(wid3 * 3 + br) * 32 + r323] / lsum : 0.f, hi3, r323, (LAS float*)(lds + 32768) + wid3 * 64); }
        }
        { const int tid4 = fresh_tid(); const int lane4 = tid4 & 63, wid4 = __builtin_amdgcn_readfirstlane(tid4 >> 6);
          const int row = lane4 >> 1, c0 = (lane4 & 1) * 32; const LAS float* src = (LAS float*)(lds + 67584) + wid4 * 2048 + row * 64 + c0;
          bf16_t* dst = onsa + ((size_t)b * 2048 + 64 * qt + 32 * (wid4 >> 2) + row) * 1024 + (4 * g + (wid4 & 3)) * 64 + c0;
#pragma unroll
          for (int q = 0; q < 4; ++q) { u32x4v w;
              w.x = cvtpk(src[8 * q], src[8 * q + 1]); w.y = cvtpk(src[8 * q + 2], src[8 * q + 3]); w.z = cvtpk(src[8 * q + 4], src[8 * q + 5]); w.w = cvtpk(src[8 * q + 6], src[8 * q + 7]);
              *(u32x4v*)(dst + 8 * q) = w; } }
        __syncthreads();
      }
    }
}

__device__ __forceinline__ size_t ph_off(int row, int col) {
    const int r = row & 255, c = col & 255;
    return (size_t)((row >> 8) * 8 + (col >> 8)) * 65536 + (((r >> 6) & 1) * 4 + ((c >> 5) & 3)) * 8192 + ((((r >> 7) * 4 + ((r >> 4) & 3)) * 2 + (c >> 7)) * 64 + ((c >> 3) & 3) * 16 + (r & 15)) * 8 + (c & 7);
}
namespace hg {
typedef short bf16x8 __attribute__((ext_vector_type(8)));
typedef short s16x4 __attribute__((ext_vector_type(4)));
typedef float f32x4 __attribute__((ext_vector_type(4)));
typedef unsigned u32x4 __attribute__((ext_vector_type(4)));
constexpr int QS = 136, TS = 40, OS = 132;
constexpr int QD_OFF = 0, KI_OFF = 8704, KET_OFF = 17408, VT_OFF = 27648, DEC_OFF = 37888, PART_OFF = 38400, OB_OFF = 40448;
__device__ __forceinline__ unsigned cvtpk(float lo, float hi) { typedef float f32x2_t __attribute__((ext_vector_type(2))); typedef __bf16 bf16x2_t __attribute__((ext_vector_type(2))); f32x2_t v = {lo, hi}; bf16x2_t b = __builtin_convertvector(v, bf16x2_t); return __builtin_bit_cast(unsigned, b); }
__device__ __forceinline__ bf16x8 pack8(const f32x4& a, const f32x4& b) { u32x4 w = {cvtpk(a[0], a[1]), cvtpk(a[2], a[3]), cvtpk(b[0], b[1]), cvtpk(b[2], b[3])}; return __builtin_bit_cast(bf16x8, w); }
__device__ __forceinline__ bf16x8 cat8(s16x4 a, s16x4 b) { bf16x8 r = {a[0], a[1], a[2], a[3], b[0], b[1], b[2], b[3]}; return r; }
}
constexpr int HP_PITCH = 25088;
__device__ __forceinline__ void ph_hgrn_pre(const Params& p, unsigned char* smem, int first, int stride) {
    using namespace hg;
    const int tidx = fresh_tid();
    const int d = tidx & 127, tq = tidx >> 7;
    float* PART = (float*)smem;
    for (int item = first; item < 4096; item += stride) {
        const int bh = item >> 6, c = item & 63, b = bh >> 2, h = bh & 3;
        const bf16_t* ph = (const bf16_t*)(p.ws + WS_PH); const int prow = b * 2048 + c * 32 + 8 * tq;
        unsigned char* blk = (unsigned char*)p.out + DO_HP + (size_t)item * HP_PITCH;
        const float lbv = ((const float*)(p.ws + WS_LB))[h * 128 + d];
        float lf[8], kk[8], qs[8];
#pragma unroll
        for (int i = 0; i < 8; ++i) { const float hq = bf2f(ph[ph_off(prow + i, h * 128 + d)]);
            const float f = lbv + (1.0f - lbv) * sigmoidf_(bf2f(ph[ph_off(prow + i, 512 + h * 128 + d)])); lf[i] = __logf(f); kk[i] = 1.0f - f; qs[i] = hq * sigmoidf_(hq); }
#pragma unroll
        for (int i = 1; i < 8; ++i) lf[i] += lf[i - 1];
        __syncthreads();
        PART[tq * 128 + d] = lf[7];
        __syncthreads();
        float prefix = 0.f, bend = 0.f;
#pragma unroll
        for (int q = 0; q < 4; ++q) { const float pv = PART[q * 128 + d]; bend += pv; if (q < tq) prefix += pv; }
        float ke[8]; const float ebend = __expf(bend);
        bf16_t* qd = (bf16_t*)blk; bf16_t* ki_ = (bf16_t*)(blk + 8192);
#pragma unroll
        for (int i = 0; i < 8; ++i) { const float eb = __expf(prefix + lf[i]), einv = __builtin_amdgcn_rcpf(eb), ki = kk[i] * einv;
            qd[(8 * tq + i) * 128 + d] = f2bf(qs[i] * eb); ki_[(8 * tq + i) * 128 + d] = f2bf(ki); ke[i] = ki * ebend; }
        const u32x4 w = {cvtpk(ke[0], ke[1]), cvtpk(ke[2], ke[3]), cvtpk(ke[4], ke[5]), cvtpk(ke[6], ke[7])};
        *(u32x4*)(blk + 16384 + (d * 32 + 8 * tq) * 2) = w;
        if (tq == 0) ((float*)(blk + 24576))[d] = ebend;
    }
}
__device__ __forceinline__ void ph_hgrn(const Params& p, unsigned char* smem, int item) {
    using namespace hg;
    const int tidx = fresh_tid();
    const int lane = tidx & 63, l15 = lane & 15, g = lane >> 4, wid = __builtin_amdgcn_readfirstlane(tidx >> 6), e0 = 16 * wid;
    const int b = item >> 2, h = item & 3, d = tidx & 127, tq = tidx >> 7;
    const bf16_t* ph = (const bf16_t*)(p.ws + WS_PH); bf16_t* oh = (bf16_t*)(p.ws + WS_HBF) + (size_t)b * 2048 * 1024 + 512;
    const unsigned char* hp = (const unsigned char*)p.out + DO_HP + (size_t)item * 64 * HP_PITCH;
    LAS char* lds = (LAS char*)smem;
    LAS float* OB = (LAS float*)(lds + OB_OFF);
    const int qoff = (tidx >> 4) * (QS * 2) + (tidx & 15) * 16, koff_ = (tidx >> 2) * (TS * 2) + (tidx & 3) * 16;
    u32x4 sqA, skA, seA, sdA, gwA, sqB, skB, seB, sdB, gwB; unsigned rvA[8], rvB[8];
    const int t_o = tidx >> 4, eg = tidx & 15;
    const float4 n0 = *(const float4*)(p.out_norm + 8 * eg), n1 = *(const float4*)(p.out_norm + 8 * eg + 4);
    auto ldset = [&](int c, u32x4& sq, u32x4& sk, u32x4& se, u32x4& sd, unsigned (&rv)[8]) __attribute__((always_inline)) {
        const unsigned char* blk = hp + (size_t)c * HP_PITCH; sq = *(const u32x4*)(blk + tidx * 16); sk = *(const u32x4*)(blk + 8192 + tidx * 16); se = *(const u32x4*)(blk + 16384 + tidx * 16);
        sd = *(const u32x4*)(blk + 24576 + (tidx & 31) * 16);
#pragma unroll
        for (int i = 0; i < 8; ++i) rv[i] = ph[ph_off(b * 2048 + c * 32 + 8 * tq + i, 1024 + h * 128 + d)];
    };
    auto ldgate = [&](int c, u32x4& gw) __attribute__((always_inline)) { gw = *(const u32x4*)(ph + ph_off(b * 2048 + c * 32 + t_o, 1536 + h * 128 + 8 * eg)); };
    f32x4 S[8];
#pragma unroll
    for (int dt = 0; dt < 8; ++dt) S[dt] = (f32x4){0.f, 0.f, 0.f, 0.f};
    auto chunk = [&](int c, u32x4& sq, u32x4& sk, u32x4& se, u32x4& sd, u32x4& gw, unsigned (&rv)[8]) __attribute__((always_inline)) {
        *(LAS u32x4*)(lds + QD_OFF + qoff) = sq; *(LAS u32x4*)(lds + KI_OFF + qoff) = sk; *(LAS u32x4*)(lds + KET_OFF + koff_) = se;
        if (tidx < 32) *(LAS u32x4*)(lds + DEC_OFF + tidx * 16) = sd;
#pragma unroll
        for (int i = 0; i < 8; ++i) asm volatile("" : "+v"(rv[i]));
        { u32x4 w = {rv[0] | (rv[1] << 16), rv[2] | (rv[3] << 16), rv[4] | (rv[5] << 16), rv[6] | (rv[7] << 16)};
          *(LAS u32x4*)(lds + VT_OFF + (d * TS + 8 * tq) * 2) = w; }
        ldset(min(c + 2, 63), sq, sk, se, sd, rv);
        __syncthreads();
        {
            bf16x8 qf[2][4], kf[2][4];
#pragma unroll
            for (int tt = 0; tt < 2; ++tt)
#pragma unroll
                for (int ks = 0; ks < 4; ++ks) { const int off = ((16 * tt + l15) * QS + 32 * ks + 4 * g) * 2;
                    qf[tt][ks] = cat8(*(const LAS s16x4*)(lds + QD_OFF + off), *(const LAS s16x4*)(lds + QD_OFF + off + 32));
                    kf[tt][ks] = cat8(*(const LAS s16x4*)(lds + KI_OFF + off), *(const LAS s16x4*)(lds + KI_OFF + off + 32)); }
            f32x4 at00 = {0.f, 0.f, 0.f, 0.f}, at01 = at00, at11 = at00;
#pragma unroll
            for (int ks = 0; ks < 4; ++ks) {
                at00 = __builtin_amdgcn_mfma_f32_16x16x32_bf16(kf[0][ks], qf[0][ks], at00, 0, 0, 0);
                at01 = __builtin_amdgcn_mfma_f32_16x16x32_bf16(kf[0][ks], qf[1][ks], at01, 0, 0, 0);
                at11 = __builtin_amdgcn_mfma_f32_16x16x32_bf16(kf[1][ks], qf[1][ks], at11, 0, 0, 0); }
#pragma unroll
            for (int r = 0; r < 4; ++r) if (4 * g + r > l15) { at00[r] = 0.f; at11[r] = 0.f; }
            const f32x4 zero4 = {0.f, 0.f, 0.f, 0.f};
            const bf16x8 a0 = pack8(at00, zero4), a1 = pack8(at01, at11);
            const int voff = VT_OFF + ((e0 + l15) * TS) * 2;
            const bf16x8 vp = cat8(*(const LAS s16x4*)(lds + voff + 8 * g), *(const LAS s16x4*)(lds + voff + 8 * g + 32));
            f32x4 o0 = __builtin_amdgcn_mfma_f32_16x16x32_bf16(a0, vp, zero4, 0, 0, 0), o1 = __builtin_amdgcn_mfma_f32_16x16x32_bf16(a1, vp, zero4, 0, 0, 0);
#pragma unroll
            for (int ks = 0; ks < 4; ++ks) { const bf16x8 sf = pack8(S[2 * ks], S[2 * ks + 1]);
                o0 = __builtin_amdgcn_mfma_f32_16x16x32_bf16(qf[0][ks], sf, o0, 0, 0, 0); o1 = __builtin_amdgcn_mfma_f32_16x16x32_bf16(qf[1][ks], sf, o1, 0, 0, 0); }
            const bf16x8 vn = *(const LAS bf16x8*)(lds + voff + 16 * g);
#pragma unroll
            for (int dt = 0; dt < 8; ++dt) { const f32x4 dc = *(const LAS f32x4*)(lds + DEC_OFF + (16 * dt + 4 * g) * 4);
                const bf16x8 kef = *(const LAS bf16x8*)(lds + KET_OFF + ((16 * dt + l15) * TS + 8 * g) * 2);
                S[dt] = __builtin_amdgcn_mfma_f32_16x16x32_bf16(kef, vn, S[dt] * dc, 0, 0, 0); }
#pragma unroll
            for (int r = 0; r < 4; ++r) { OB[(4 * g + r) * OS + e0 + l15] = o0[r]; OB[(16 + 4 * g + r) * OS + e0 + l15] = o1[r]; }
        }
        __syncthreads();
        { const int t = t_o; const size_t row = (size_t)c * 32 + t;
          const f32x4 x0 = *(const LAS f32x4*)(lds + OB_OFF + (t * OS + 8 * eg) * 4), x1 = *(const LAS f32x4*)(lds + OB_OFF + (t * OS + 8 * eg + 4) * 4);
          float ss = (x0[0] * x0[0] + x0[1] * x0[1]) + (x0[2] * x0[2] + x0[3] * x0[3]) + (x1[0] * x1[0] + x1[1] * x1[1]) + (x1[2] * x1[2] + x1[3] * x1[3]);
          ss += xor_get<1>(ss); ss += xor_get<2>(ss); ss += xor_get<4>(ss); ss += xor_get<8>(ss);
          const float rstd = rsqrtf(ss * (1.0f / 128.0f) + 1e-6f);
          const float gv[8] = {__uint_as_float(gw[0] << 16), __uint_as_float(gw[0] & 0xffff0000u), __uint_as_float(gw[1] << 16), __uint_as_float(gw[1] & 0xffff0000u),
                               __uint_as_float(gw[2] << 16), __uint_as_float(gw[2] & 0xffff0000u), __uint_as_float(gw[3] << 16), __uint_as_float(gw[3] & 0xffff0000u)};
          const float xv[8] = {x0[0], x0[1], x0[2], x0[3], x1[0], x1[1], x1[2], x1[3]}; const float nv[8] = {n0.x, n0.y, n0.z, n0.w, n1.x, n1.y, n1.z, n1.w};
          float r[8];
#pragma unroll
          for (int i = 0; i < 8; ++i) r[i] = xv[i] * rstd * nv[i] * (gv[i] * sigmoidf_(gv[i]));
          const u32x4 w = {cvtpk(r[0], r[1]), cvtpk(r[2], r[3]), cvtpk(r[4], r[5]), cvtpk(r[6], r[7])};
          *(u32x4*)(oh + row * 1024 + h * 128 + 8 * eg) = w; }
        ldgate(min(c + 2, 63), gw);
    };
    ldset(0, sqA, skA, seA, sdA, rvA); ldgate(0, gwA); ldset(1, sqB, skB, seB, sdB, rvB); ldgate(1, gwB);
    for (int c = 0; c < 64; c += 2) { chunk(c, sqA, skA, seA, sdA, gwA, rvA); chunk(c + 1, sqB, skB, seB, sdB, gwB, rvB); }
}

__device__ __forceinline__ bool peer_item(int w, int r, int& h, int& ti) { if (r >= 2) return false; const int i = (w >> 3) + 32 * r; h = i & 7; ti = (w & 7) + 8 * (i >> 3); return true; }
__device__ __forceinline__ int f2key(float f) { const int b = __float_as_int(f); return b ^ ((b >> 31) & 0x7fffffff); }
__device__ __forceinline__ float key2f(int k) { return __int_as_float(k ^ ((k >> 31) & 0x7fffffff)); }
__device__ __forceinline__ float key2h(int k) { const unsigned x = (unsigned)(k ^ ((k >> 31) & 0x7fffffff)); return (float)__builtin_bit_cast(_Float16, (unsigned short)(x >> 16)); }
__device__ __forceinline__ void ce_desc(int& a, int& b) { const int hi = max(a, b), lo = min(a, b); a = hi; b = lo; }
__device__ __forceinline__ void sort16_desc(int (&a)[16]) {
#pragma unroll
    for (int k = 2; k <= 16; k <<= 1)
#pragma unroll
        for (int j = k >> 1; j > 0; j >>= 1)
#pragma unroll
            for (int i = 0; i < 16; ++i) { const int l = i ^ j; if (l > i) { if ((i & k) == 0) ce_desc(a[i], a[l]); else ce_desc(a[l], a[i]); } }
}
__device__ __forceinline__ void merge16_desc(int (&a)[16]) {
#pragma unroll
    for (int j = 8; j > 0; j >>= 1)
#pragma unroll
        for (int i = 0; i < 16; ++i) { const int l = i ^ j; if (l > i) ce_desc(a[i], a[l]); }
}
__device__ __forceinline__ void topmerge16(int (&T)[16], int (&G)[16]) {
#pragma unroll
    for (int i = 0; i < 16; ++i) T[i] = max(T[i], G[15 - i]);
    merge16_desc(T);
}
__device__ __forceinline__ constexpr int cand_a(int s) { int c = 0; for (int a = 0; a < 16; ++a) { const int nb = 16 / (a + 1); if (s < c + nb) return a; c += nb; } return -1; }
__device__ __forceinline__ constexpr int cand_b(int s) { int c = 0; for (int a = 0; a < 16; ++a) { const int nb = 16 / (a + 1); if (s < c + nb) return s - c; c += nb; } return -1; }
__device__ __forceinline__ void ph_peer_topk(const Params& p, int* tl) {
    const int tidx = fresh_tid();
    const bf16_t* ST = (const bf16_t*)(p.ws + WS_Q); int* exi = (int*)(p.ws + WS_EXI); float* exw = (float*)(p.ws + WS_EXW);
    const int tid = tidx;
    for (int r = 0; r < 2; ++r) {
        int h, ti; peer_item((int)blockIdx.x, r, h, ti); const int tok = ti * 512 + tid;
        int T1[16], T[16], G[16];
        const int r_ = tok & 255; const _Float16* src0 = (const _Float16*)ST + (size_t)((tok >> 8) * 8 + h) * 65536 + ((r_ >> 6) & 1) * 32768 + (r_ >> 7) * 4096 + ((r_ >> 4) & 3) * 1024 + (r_ & 15) * 8;
#define SCORE_GOFF(gg) ((((gg) >> 3) * 512) + ((((gg) >> 1) & 3) * 8192) + (((gg) & 1) * 256))
        typedef _Float16 h8_ __attribute__((ext_vector_type(8)));
        h8_ ra = *(const h8_*)(src0 + SCORE_GOFF(0)), rb = *(const h8_*)(src0 + SCORE_GOFF(0) + 128);
#pragma unroll
        for (int gg = 0; gg < 16; ++gg) {
#pragma unroll
            for (int i = 0; i < 8; ++i) { G[i] = (f2key((float)ra[i]) & ~0x7f) | ((gg & 7) * 16 + i); G[8 + i] = (f2key((float)rb[i]) & ~0x7f) | ((gg & 7) * 16 + 8 + i); }
            if (gg < 15) { ra = *(const h8_*)(src0 + SCORE_GOFF(gg + 1)); rb = *(const h8_*)(src0 + SCORE_GOFF(gg + 1) + 128); }
            sort16_desc(G);
            if ((gg & 7) == 0) {
#pragma unroll
                for (int i = 0; i < 16; ++i) T[i] = G[i];
            } else topmerge16(T, G);
            if (gg == 7) {
#pragma unroll
                for (int i = 0; i < 16; ++i) T1[i] = T[i];
            }
        }
        __syncthreads();
#pragma unroll
        for (int i = 0; i < 16; ++i) { tl[i * 512 + tid] = T1[i] & 0x7f; tl[(16 + i) * 512 + tid] = T[i] & 0x7f; }
        float v1[16], v2[16];
#pragma unroll
        for (int i = 0; i < 16; ++i) { v1[i] = key2f(T1[i] & ~0x7f); v2[i] = key2f(T[i] & ~0x7f); }
        int R[16];
#pragma unroll
        for (int grp = 0; grp < 4; ++grp) {
#pragma unroll
            for (int i = 0; i < 16; ++i) { constexpr int dummy = 0; (void)dummy; const int sidx = grp * 16 + i; const int a = cand_a(sidx), b = cand_b(sidx);
                G[i] = (a >= 0) ? ((f2key(v1[a >= 0 ? a : 0] + v2[b >= 0 ? b : 0]) & ~0xff) | (a << 4) | b) : (int)0x80000000; }
            sort16_desc(G);
            if (grp == 0) {
#pragma unroll
                for (int i = 0; i < 16; ++i) R[i] = G[i];
            } else topmerge16(R, G);
        }
        float e[16]; float z = 0.f; const float mx = key2f(R[0] & ~0xff);
#pragma unroll
        for (int i = 0; i < 16; ++i) { e[i] = __expf(key2f(R[i] & ~0xff) - mx); z += e[i]; }
        const float rz = 1.0f / z;
        int ids[16];
#pragma unroll
        for (int i = 0; i < 16; ++i) { const int a = (R[i] >> 4) & 15, b = R[i] & 15; ids[i] = tl[a * 512 + tid] * 128 + tl[(16 + b) * 512 + tid]; }
        int4* di = (int4*)(exi + (size_t)tok * 128 + h * 16); float4* dw = (float4*)(exw + (size_t)tok * 128 + h * 16);
#pragma unroll
        for (int q = 0; q < 4; ++q) { di[q] = make_int4(ids[4 * q], ids[4 * q + 1], ids[4 * q + 2], ids[4 * q + 3]); dw[q] = make_float4(e[4 * q] * rz, e[4 * q + 1] * rz, e[4 * q + 2] * rz, e[4 * q + 3] * rz); }
    }
}
typedef int v4i __attribute__((ext_vector_type(4)));
__device__ __forceinline__ void ph_peer_u(const Params& p, int* sm) {
    const int tidx = fresh_tid();
    const signed char* u8 = (const signed char*)(p.ws + WS_U); const float* su = (const float*)(p.ws + WS_SU); const signed char* x8 = (const signed char*)(p.ws + WS_X8); const float* sx = (const float*)(p.ws + WS_SX);
    const int* exi = (const int*)(p.ws + WS_EXI); float* aout = (float*)(p.ws + WS_AOUT); const float* exw = (const float*)(p.ws + WS_EXW); const float* sv = (const float*)(p.ws + WS_SV);
    const int wave = __builtin_amdgcn_readfirstlane(tidx >> 6), lane = tidx & 63, j = blockIdx.x & 7, lw = blockIdx.x >> 3, nlw = gridDim.x >> 3, sub = lane & 7, grp = lane >> 3;
    const __amdgpu_buffer_rsrc_t urs = __builtin_amdgcn_make_buffer_rsrc((void*)(u8 + (size_t)j * (2048 * 1024)), (short)0, 2048 * 1024, 0x00020000);
    int2* lst = (int2*)sm + wave * 1024;
    signed char* xs = (signed char*)(sm + 16 * 1024) + wave * (8 * 1152);
    const float2* suv = (const float2*)(p.ws + WS_SUV);
    for (int tb = lw * 8 + wave; tb < NTOK / 8; tb += nlw * 8) {
        const int tok0 = tb * 8;
        int4 ev[4]; float4 gv[4]; int cnt = 0;
#pragma unroll
        for (int q = 0; q < 4; ++q) { ev[q] = *(const int4*)(exi + (size_t)tok0 * 128 + q * 256 + lane * 4); gv[q] = *(const float4*)(exw + (size_t)tok0 * 128 + q * 256 + lane * 4);
            cnt += ((ev[q].x >> 11) == j) + ((ev[q].y >> 11) == j) + ((ev[q].z >> 11) == j) + ((ev[q].w >> 11) == j); }
        v4i xr0 = *(const v4i*)(x8 + (size_t)(tok0 + 0) * 1024 + lane * 16), xr1 = *(const v4i*)(x8 + (size_t)(tok0 + 1) * 1024 + lane * 16), xr2 = *(const v4i*)(x8 + (size_t)(tok0 + 2) * 1024 + lane * 16), xr3 = *(const v4i*)(x8 + (size_t)(tok0 + 3) * 1024 + lane * 16);
        v4i xr4 = *(const v4i*)(x8 + (size_t)(tok0 + 4) * 1024 + lane * 16), xr5 = *(const v4i*)(x8 + (size_t)(tok0 + 5) * 1024 + lane * 16), xr6 = *(const v4i*)(x8 + (size_t)(tok0 + 6) * 1024 + lane * 16), xr7 = *(const v4i*)(x8 + (size_t)(tok0 + 7) * 1024 + lane * 16);
        const float sxv = sx[tok0 + (lane & 7)];
        int incl = cnt;
#pragma unroll
        for (int o = 1; o < 64; o <<= 1) { const int v = __shfl_up(incl, o); if (lane >= o) incl += v; }
        int pos = incl - cnt; const int total = __builtin_amdgcn_readlane(incl, 63);
        wave_lds_sync();
#pragma unroll
        for (int q = 0; q < 4; ++q) { const int tq_ = (q * 2 + (lane >> 5)) << 21, s0 = (lane & 31) * 4;
            if ((ev[q].x >> 11) == j) lst[pos++] = make_int2(ev[q].x | ((s0 + 0) << 14) | tq_, __float_as_int(gv[q].x));
            if ((ev[q].y >> 11) == j) lst[pos++] = make_int2(ev[q].y | ((s0 + 1) << 14) | tq_, __float_as_int(gv[q].y));
            if ((ev[q].z >> 11) == j) lst[pos++] = make_int2(ev[q].z | ((s0 + 2) << 14) | tq_, __float_as_int(gv[q].z));
            if ((ev[q].w >> 11) == j) lst[pos++] = make_int2(ev[q].w | ((s0 + 3) << 14) | tq_, __float_as_int(gv[q].w)); }
        { signed char* xd = xs + lane * 16; *(v4i*)(xd) = xr0; *(v4i*)(xd + 1152) = xr1; *(v4i*)(xd + 2 * 1152) = xr2; *(v4i*)(xd + 3 * 1152) = xr3;
          *(v4i*)(xd + 4 * 1152) = xr4; *(v4i*)(xd + 5 * 1152) = xr5; *(v4i*)(xd + 6 * 1152) = xr6; *(v4i*)(xd + 7 * 1152) = xr7; }
        wave_lds_sync();
#pragma unroll 2
        for (int it = 0; it * 8 < total; ++it) {
            const int i = it * 8 + grp; const bool valid = i < total; const int2 en2 = valid ? lst[i] : make_int2(j << 11, 0); const int ent = en2.x;
            const int e = ent & 0x3fff, ti = (ent >> 21) & 7;
            const int aoff = ((e & 2047) << 10) + sub * 16; const signed char* xp = xs + ti * 1152 + sub * 16;
            const float2 sc2 = suv[e];
            int acc = 0;
#pragma unroll
            for (int st = 0; st < 8; ++st) { const v4i a = __builtin_amdgcn_raw_buffer_load_b128(urs, aoff + st * 128, 0, 0); const int4 x = *(const int4*)(xp + st * 128);
                acc = __builtin_amdgcn_sdot4(a[0], x.x, acc, false); acc = __builtin_amdgcn_sdot4(a[1], x.y, acc, false); acc = __builtin_amdgcn_sdot4(a[2], x.z, acc, false); acc = __builtin_amdgcn_sdot4(a[3], x.w, acc, false); }
            acc += xor_get<1>(acc); acc += xor_get<2>(acc); acc += xor_get<4>(acc);
            const float sxt = __shfl(sxv, ti);
            if (valid && sub == 0) aout[(size_t)(tok0 + ti) * 128 + ((ent >> 14) & 127)] = __int_as_float(en2.y) * gelu_tanh((float)acc * sc2.x * sxt) * sc2.y;
        }
    }
}
typedef short s16x2 __attribute__((ext_vector_type(2)));
__device__ __forceinline__ int dot2b(unsigned x, unsigned y, unsigned sel, unsigned wpair, int acc) { return __builtin_amdgcn_sdot2(__builtin_bit_cast(s16x2, __builtin_amdgcn_perm(y, x, sel)), __builtin_bit_cast(s16x2, wpair), acc, false); }
__device__ __forceinline__ void ph_peer_v(const Params& p, float* sm, bool dry = false) {
    const int tidx = fresh_tid();
    const unsigned char* v8 = (const unsigned char*)(p.ws + WS_V); const float* sv = (const float*)(p.ws + WS_SV);
    const int* exi = (const int*)(p.ws + WS_EXI); const float* exw = (const float*)(p.ws + WS_EXW); const float* aout = (const float*)(p.ws + WS_AOUT);
    const float* mod = (const float*)(p.ws + WS_MOD); float* ssp = (float*)(p.ws + WS_SSP);
    const int wave = __builtin_amdgcn_readfirstlane(tidx >> 6), lane = tidx & 63, j = blockIdx.x & 7, lw = blockIdx.x >> 3, nlw = gridDim.x >> 3, sub = lane & 7, tk = lane >> 3;
    int* we = (int*)sm + wave * 2048; unsigned* wp = (unsigned*)(we + 1024); float* wsc = (float*)(we + 1536); int* wcorr = we + 1544;
    for (int tb = lw * 8 + wave; tb < NTOK / 8; tb += nlw * 8) {
        const int tok0 = tb * 8;
        wave_lds_sync();
        { const size_t i0 = (size_t)(tok0 + tk) * 128 + sub * 16;
          int4 e4[4]; float4 w4[4];
#pragma unroll
          for (int q = 0; q < 4; ++q) { e4[q] = *(const int4*)(exi + i0 + 4 * q); w4[q] = *(const float4*)(aout + i0 + 4 * q); }
          float wmax = 0.f;
#pragma unroll
          for (int q = 0; q < 4; ++q) wmax = fmaxf(fmaxf(wmax, fmaxf(fabsf(w4[q].x), fabsf(w4[q].y))), fmaxf(fabsf(w4[q].z), fabsf(w4[q].w)));
          wmax = fmaxf(wmax, xor_get<1>(wmax)); wmax = fmaxf(wmax, xor_get<2>(wmax)); wmax = fmaxf(wmax, xor_get<4>(wmax));
          const float sc = wmax > 0.f ? 32767.0f / wmax : 0.f;
          int sum = 0;
#pragma unroll
          for (int q = 0; q < 4; ++q) { const int q0 = (int)rintf(w4[q].x * sc), q1 = (int)rintf(w4[q].y * sc), q2 = (int)rintf(w4[q].z * sc), q3 = (int)rintf(w4[q].w * sc);
              sum += (q0 + q1) + (q2 + q3);
              *(int4*)(we + tk * 128 + sub * 16 + 4 * q) = make_int4(e4[q].x << 7, e4[q].y << 7, e4[q].z << 7, e4[q].w << 7);
              *(uint2*)(wp + tk * 64 + sub * 8 + 2 * q) = make_uint2((unsigned)(q0 & 0xffff) | ((unsigned)q1 << 16), (unsigned)(q2 & 0xffff) | ((unsigned)q3 << 16)); }
          sum += xor_get<1>(sum); sum += xor_get<2>(sum); sum += xor_get<4>(sum);
          if (sub == 0) { wsc[tk] = wmax * (1.0f / 32767.0f); wcorr[tk] = 128 * sum; } }
        wave_lds_sync();
        int acc[16];
#pragma unroll
        for (int c = 0; c < 16; ++c) acc[c] = 0;
        const __amdgpu_buffer_rsrc_t vrs = __builtin_amdgcn_make_buffer_rsrc((void*)(v8 + (size_t)j * (16384 * 128)), (short)0, 16384 * 128, 0x00020000);
#pragma unroll 8
        for (int kp = 0; kp < 64; ++kp) {
            const int2 ee = *(const int2*)(we + tk * 128 + 2 * kp); const unsigned wpair = wp[tk * 64 + kp];
            const v4i X = __builtin_amdgcn_raw_buffer_load_b128(vrs, ee.x + sub * 16, 0, 0), Y = __builtin_amdgcn_raw_buffer_load_b128(vrs, ee.y + sub * 16, 0, 0);
            const unsigned xx[4] = {(unsigned)X[0], (unsigned)X[1], (unsigned)X[2], (unsigned)X[3]}, yy[4] = {(unsigned)Y[0], (unsigned)Y[1], (unsigned)Y[2], (unsigned)Y[3]};
#pragma unroll
            for (int d = 0; d < 4; ++d) {
                acc[4 * d + 0] = dot2b(xx[d], yy[d], 0x0c040c00u, wpair, acc[4 * d + 0]); acc[4 * d + 1] = dot2b(xx[d], yy[d], 0x0c050c01u, wpair, acc[4 * d + 1]);
                acc[4 * d + 2] = dot2b(xx[d], yy[d], 0x0c060c02u, wpair, acc[4 * d + 2]); acc[4 * d + 3] = dot2b(xx[d], yy[d], 0x0c070c03u, wpair, acc[4 * d + 3]); }
        }
        const float ws_ = wsc[tk]; const int corr = wcorr[tk];
        const int tok = tok0 + tk, col0 = j * 128 + sub * 16; const float* gt = mod + (tok >> 11) * 6144 + 5120 + col0; bf16_t* xo = (bf16_t*)(p.ws + WS_X1B) + (size_t)tok * 1024 + col0;
        float ss = 0.f;
#pragma unroll
        for (int q = 0; q < 2; ++q) { const uint4 xw = *(const uint4*)(xo + 8 * q); const float4 ga = *(const float4*)(gt + 8 * q), gb = *(const float4*)(gt + 8 * q + 4);
            const float r0 = __uint_as_float(xw.x << 16) + ga.x * (ws_ * (float)(acc[8 * q] - corr)), r1 = __uint_as_float(xw.x & 0xffff0000u) + ga.y * (ws_ * (float)(acc[8 * q + 1] - corr));
            const float r2 = __uint_as_float(xw.y << 16) + ga.z * (ws_ * (float)(acc[8 * q + 2] - corr)), r3 = __uint_as_float(xw.y & 0xffff0000u) + ga.w * (ws_ * (float)(acc[8 * q + 3] - corr));
            const float r4 = __uint_as_float(xw.z << 16) + gb.x * (ws_ * (float)(acc[8 * q + 4] - corr)), r5 = __uint_as_float(xw.z & 0xffff0000u) + gb.y * (ws_ * (float)(acc[8 * q + 5] - corr));
            const float r6 = __uint_as_float(xw.w << 16) + gb.z * (ws_ * (float)(acc[8 * q + 6] - corr)), r7 = __uint_as_float(xw.w & 0xffff0000u) + gb.w * (ws_ * (float)(acc[8 * q + 7] - corr));
            ss += ((r0 * r0 + r1 * r1) + (r2 * r2 + r3 * r3)) + ((r4 * r4 + r5 * r5) + (r6 * r6 + r7 * r7));
            if (!dry) *(uint4*)(xo + 8 * q) = make_uint4(pack2bf(r0, r1), pack2bf(r2, r3), pack2bf(r4, r5), pack2bf(r6, r7)); }
        ss += xor_get<1>(ss); ss += xor_get<2>(ss); ss += xor_get<4>(ss);
        if (sub == 0) ssp[(size_t)tok * 8 + j] = ss;
    }
}
__device__ __forceinline__ void ph_final_norm(const Params& p) {
    const int tidx = fresh_tid();
    const float* ssp = (const float*)(p.ws + WS_SSP);
    const int wave = tidx >> 6, lane = tidx & 63, wpb = blockDim.x >> 6;
    for (int row = blockIdx.x * wpb + wave; row < NTOK; row += gridDim.x * wpb) {
        float ss = 0.f;
#pragma unroll
        for (int q = 0; q < 8; ++q) ss += ssp[(size_t)row * 8 + q];
        const float rstd = rsqrtf(ss * (1.0f / 1024.0f) + 1e-6f);
        const uint2* xr = (const uint2*)((const bf16_t*)(p.ws + WS_X1B) + (size_t)row * 1024); float4* orow = (float4*)(p.out + (size_t)row * 1024);
#pragma unroll
        for (int i = 0; i < 4; ++i) { const uint2 w = xr[lane + 64 * i]; const float4 g = *(const float4*)(p.g_final + (lane + 64 * i) * 4);
            orow[lane + 64 * i] = make_float4(__uint_as_float(w.x << 16) * rstd * g.x, __uint_as_float(w.x & 0xffff0000u) * rstd * g.y, __uint_as_float(w.y << 16) * rstd * g.z, __uint_as_float(w.y & 0xffff0000u) * rstd * g.w); }
    }
}

#define XB_TMO      128
#define XB_XCNT(j)  (256  + 64 * (j))
#define XB_XSUB(j)  (1280 + 64 * (j))
#define XB_XGEN(j)  (2304 + 64 * (j))
#define XB_TOP      3328
#define XB_TOPGEN   3392
#define XCD_BAR_WORDS 3456
#define XB_SPIN_CAP (1u << 22)
__device__ __forceinline__ unsigned xb_ld(unsigned* p)              { return __hip_atomic_load(p, __ATOMIC_RELAXED, __HIP_MEMORY_SCOPE_AGENT); }
__device__ __forceinline__ unsigned xb_add(unsigned* p, unsigned v) { return __hip_atomic_fetch_add(p, v, __ATOMIC_RELAXED, __HIP_MEMORY_SCOPE_AGENT); }
__device__ __forceinline__ unsigned xb_xcc_id() { return (unsigned)__builtin_amdgcn_s_getreg((3 << 11) | 20) & 0xFu; }
#define XB_SPIN(cond, bar) do { unsigned _sp = 0; while (cond) { __builtin_amdgcn_s_sleep(1); \
    if ((++_sp & 255u) == 0u) { if (xb_ld(&(bar)[XB_TMO])) break; if (_sp > XB_SPIN_CAP) { atomicAdd(&(bar)[XB_TMO], 1u); break; } } } } while (0)
struct XcdBarrier { unsigned* bar; unsigned x; volatile LAS unsigned* st; };
__device__ __forceinline__ XcdBarrier xcd_barrier_post(unsigned* bar, volatile LAS unsigned* st) {
    XcdBarrier b; b.bar = bar; b.x = xb_xcc_id(); b.st = st;
    if (threadIdx.x == 0) (void)xb_add(&bar[XB_XCNT(b.x)], 1u);
    return b;
}
__device__ __forceinline__ void xcd_barrier_complete(unsigned* bar, unsigned x, unsigned& nloc, unsigned& nx) {
    const unsigned G = gridDim.x * gridDim.y * gridDim.z;
    unsigned sum, cnt, mine, sp = 0u;
    for (;;) {
        sum = 0u; cnt = 0u; mine = 0u;
#pragma unroll
        for (unsigned j = 0; j < 16; ++j) { const unsigned c = xb_ld(&bar[XB_XCNT(j)]); sum += c; cnt += (c > 0u) ? 1u : 0u; mine = (j == x) ? c : mine; }
        if (sum == G) break;
        __builtin_amdgcn_s_sleep(1);
        if ((++sp & 255u) == 0u) { if (xb_ld(&bar[XB_TMO])) break; if (sp > XB_SPIN_CAP) { atomicAdd(&bar[XB_TMO], 1u); break; } }
    }
    nloc = mine > 0u ? mine : 1u; nx = cnt > 0u ? cnt : 1u;
}
__device__ __forceinline__ void xcd_barrier(const XcdBarrier& b) {
    asm volatile("s_waitcnt vmcnt(0)" ::: "memory");
    __syncthreads();
    if (threadIdx.x == 0) {
        unsigned* bar = b.bar;
        __builtin_amdgcn_s_waitcnt(0);
        unsigned nloc = b.st[0], nx = b.st[1];
        if (nloc == 0u) { xcd_barrier_complete(bar, b.x, nloc, nx); b.st[0] = nloc; b.st[1] = nx; }
        const unsigned old = xb_add(&bar[XB_XSUB(b.x)], 1u);
        const unsigned gen = old / nloc;
        if (old + 1u == (gen + 1u) * nloc) {
            __builtin_amdgcn_fence(__ATOMIC_RELEASE, "agent");
            asm volatile("s_waitcnt vmcnt(0)" ::: "memory");
            const unsigned og = xb_add(&bar[XB_TOP], 1u);
            const unsigned tg = og / nx;
            if (og + 1u == (tg + 1u) * nx) xb_add(&bar[XB_TOPGEN], 1u);
            else XB_SPIN(xb_ld(&bar[XB_TOPGEN]) == tg, bar);
            __builtin_amdgcn_fence(__ATOMIC_ACQUIRE, "agent");
            xb_add(&bar[XB_XGEN(b.x)], 1u);
            asm volatile("s_waitcnt vmcnt(0)" ::: "memory");
        } else {
            XB_SPIN(xb_ld(&bar[XB_XGEN(b.x)]) == gen, bar);
            __builtin_amdgcn_fence(__ATOMIC_ACQUIRE, "agent");
            asm volatile("s_waitcnt vmcnt(0)" ::: "memory");
        }
    }
    __syncthreads();
}

struct ScoreOrder {
    int w, G;
    __device__ __forceinline__ bool next(int i, pg8::Unit& u) const { int h, ti; if (!peer_item(w, i >> 1, h, ti)) return false; u.pm = 2 * ti + (i & 1); u.pn = h; return true; }
    __device__ __forceinline__ void a_ready(const pg8::Unit&) const {}
    __device__ __forceinline__ void done(const pg8::Unit&) const {}
};
extern __shared__ __attribute__((aligned(16))) unsigned char dyn_smem[];
template <class Epi> __device__ __forceinline__ void run_gemm(const bf16_t* A, const bf16_t* Bt, int M, int N, int K, const Epi& E) {
    pg8::Gemm g{A, Bt, M, N, K, K};
    pg8::StaticOrder S; S.init(g.M, g.N, (int)gridDim.x, (int)blockIdx.x);
    pg8::gemm_phase<Epi, pg8::StaticOrder>((LAS unsigned char*)dyn_smem, g, S, E);
}
__global__ void __launch_bounds__(512, 2) mega_fwd(Params p) {
    float* sm = (float*)dyn_smem; unsigned char* ws = p.ws;
    volatile LAS unsigned* xst = (volatile LAS unsigned*)((LAS unsigned char*)dyn_smem + (144 * 1024 - 16));
    if (threadIdx.x < 4) xst[threadIdx.x] = 0u;
    __syncthreads();
    const XcdBarrier xb = xcd_barrier_post((unsigned*)(ws + WS_BAR), xst);
#define PHASE(k, ...) { __VA_ARGS__; xcd_barrier(xb); } if (PROBE_PHASE == (k)) { __VA_ARGS__; xcd_barrier(xb); }
    PHASE(0, ph_prep(p, sm))
    PHASE(1, ph_rmsnorm_mod<false>(p.x, p.g_mix, (const float*)(ws + WS_MOD), 0, 1024, (bf16_t*)(ws + WS_HBF), nullptr, nullptr))
    PHASE(2, { pg8::EpiProj E{(bf16_t*)(ws + WS_PA), (bf16_t*)(ws + WS_PH), (bf16_t*)(ws + WS_PM), (bf16_t*)(ws + WS_PG), (bf16_t*)((unsigned char*)p.out + DO_KCC), (bf16_t*)((unsigned char*)p.out + DO_VCC),
                     (const float*)(ws + WS_ROPEC), (const float*)(ws + WS_ROPES)};
      run_gemm((const bf16_t*)(ws + WS_HBF), (const bf16_t*)(ws + WS_WIN), NTOK, NPROJ, 1024, E); })
    PHASE(3, {
    if (blockIdx.x >= 64 && blockIdx.x < 96) {
        const int which = (blockIdx.x - 64) >> 4, c = (blockIdx.x - 64) & 15;
        bf16_t* hid = (bf16_t*)((unsigned char*)p.out + DO_HID) + (size_t)which * 4096 * 128;
        pg8::Gemm g{(const bf16_t*)((unsigned char*)p.out + (which ? DO_VCC : DO_KCC)), (const bf16_t*)(ws + (which ? WS_W1TV : WS_W1TK)), 4096, 256, 2048, 1024};
        pg8::StaticOrder S; S.init(g.M, g.N, 16, c);
        pg8::EpiCompress E{hid, (const float*)(ws + WS_C0) + which * 128};
        pg8::gemm_phase<pg8::EpiCompress, pg8::StaticOrder>((LAS unsigned char*)dyn_smem, g, S, E);
        pg8::Unit u; S.next(0, u);
        compress_stage2(hid, which ? p.w_cv2 : p.w_ck2, (bf16_t*)(ws + (which ? WS_VCMP : WS_KCMP)), u.pm, which == 0, sm);
    } else ph_hgrn_pre(p, dyn_smem, blockIdx.x < 64 ? blockIdx.x : blockIdx.x - 32, gridDim.x - 32); })
    PHASE(4, { if (blockIdx.x < 64) ph_hgrn(p, dyn_smem, blockIdx.x); ph_attn(p, dyn_smem, (unsigned*)(ws + WS_BAR + 16384)); })
    PHASE(5, { pg8::EpiBranch E{(const bf16_t*)(ws + WS_PM), (bf16_t*)(ws + WS_Y)}; run_gemm((const bf16_t*)(ws + WS_HBF), (const bf16_t*)(ws + WS_WB), NTOK, 1024, 1024, E); })
    PHASE(6, { pg8::EpiResid E{p.x, (const float*)(ws + WS_MOD), (bf16_t*)(ws + WS_X1B)}; run_gemm((const bf16_t*)(ws + WS_Y), (const bf16_t*)(ws + WS_WOUT), NTOK, 1024, 1024, E); })
    PHASE(7, ph_rmsnorm_mod<true>(ws + WS_X1B, p.g_ffn, (const float*)(ws + WS_MOD), 3072, 4096, (bf16_t*)(ws + WS_HBF), (unsigned*)(ws + WS_X8), (float*)(ws + WS_SX)))
    PHASE(8, { pg8::EpiF16 E{(bf16_t*)(ws + WS_Q), 8, 0}; pg8::Gemm g{(const bf16_t*)(ws + WS_HBF), (const bf16_t*)(ws + WS_WQ), NTOK, 2048, 1024, 1024};
               ScoreOrder S{(int)blockIdx.x, (int)gridDim.x}; pg8::gemm_phase<pg8::EpiF16, ScoreOrder>((LAS unsigned char*)dyn_smem, g, S, E);
               __builtin_amdgcn_fence(__ATOMIC_ACQUIRE, "agent"); asm volatile("s_waitcnt vmcnt(0)" ::: "memory"); __syncthreads();
               ph_peer_topk(p, (int*)sm); })
    PHASE(10, ph_peer_u(p, (int*)sm))
#if PROBE_PHASE == 11
    { ph_peer_v(p, sm, true); xcd_barrier(xb); }
#endif
    { ph_peer_v(p, sm); xcd_barrier(xb); }
    ph_final_norm(p);
}

extern "C" void kernel_launch(void* const* d_in, const int* in_sizes, int n_in, void* d_out, int out_size, void* d_ws, size_t ws_size, hipStream_t stream) {
    constexpr size_t kDynLds = 144 * 1024;
    static int grid_blocks = 0;
    if (!grid_blocks) {
        if (ws_size < WS_END) { fprintf(stderr, "kernel_launch: workspace too small (%zu < %zu)\n", ws_size, (size_t)WS_END); grid_blocks = -1; return; }
        int dev = 0, cus = 0, per_cu = 0;
        hipGetDevice(&dev); hipDeviceGetAttribute(&cus, hipDeviceAttributeMultiprocessorCount, dev);
        (void)hipFuncSetAttribute((const void*)mega_fwd, hipFuncAttributeMaxDynamicSharedMemorySize, (int)kDynLds);
        hipOccupancyMaxActiveBlocksPerMultiprocessor(&per_cu, (const void*)mega_fwd, 512, kDynLds);
        if (per_cu < 1) { fprintf(stderr, "kernel_launch: occupancy query says %d blocks/CU\n", per_cu); per_cu = 1; }
        grid_blocks = cus;
    }
    if (grid_blocks < 0) return;
    Params p{};
    p.x = (const float*)d_in[0]; p.c = (const float*)d_in[1]; p.w_ada = (const float*)d_in[2]; p.b_ada = (const float*)d_in[3]; p.g_mix = (const float*)d_in[4]; p.g_ffn = (const float*)d_in[5];
    p.w_in = (const float*)d_in[6]; p.cmp_pos_k = (const float*)d_in[7]; p.cmp_pos_v = (const float*)d_in[8]; p.w_ck1 = (const float*)d_in[9]; p.w_ck2 = (const float*)d_in[10];
    p.w_cv1 = (const float*)d_in[11]; p.w_cv2 = (const float*)d_in[12]; p.lb_logits = (const float*)d_in[13]; p.out_norm = (const float*)d_in[14]; p.w_branch = (const float*)d_in[15];
    p.w_out = (const float*)d_in[16]; p.w_peer_q = (const float*)d_in[17]; p.sub_keys = (const float*)d_in[18]; p.peer_u = (const float*)d_in[19]; p.peer_v = (const float*)d_in[20]; p.g_final = (const float*)d_in[21];
    p.out = (float*)d_out; p.ws = (unsigned char*)d_ws;
    (void)hipMemsetAsync((unsigned char*)d_ws + WS_BAR, 0, 16384 + 256, stream);
    void* args[] = {&p};
    hipError_t e = hipLaunchCooperativeKernel((const void*)mega_fwd, dim3(grid_blocks), dim3(512), args, kDynLds, stream);
    if (e != hipSuccess) fprintf(stderr, "cooperative launch failed: %s (grid %d)\n", hipGetErrorString(e), grid_blocks);
}
```

```cpp
#include <hip/hip_runtime.h>
#include <hip/hip_bf16.h>
#include <hip/hip_cooperative_groups.h>
namespace cg = cooperative_groups;
#include <cstdio>
#include <cstdint>

#ifndef PROBE_PHASE
#define PROBE_PHASE -1
#endif
typedef unsigned short bf16_t;
#define LAS __attribute__((address_space(3)))

constexpr int DM = 1024, NB = 16, SEQ = 2048, NTOK = NB * SEQ;
constexpr int IN_COLS = 5400, NPROJ = 5632;
constexpr size_t MiB = 1ull << 20;
constexpr size_t WS_WIN = 0;
constexpr size_t WS_WB = 11 * MiB;
constexpr size_t WS_WOUT = 13 * MiB;
constexpr size_t WS_WQ = 15 * MiB;
constexpr size_t WS_U = 19 * MiB;
constexpr size_t WS_V = 51 * MiB;
constexpr size_t WS_SMALL = 83 * MiB;
constexpr size_t WS_MOD = WS_SMALL;
constexpr size_t WS_ROPEC = WS_MOD + 16 * 6144 * 4;
constexpr size_t WS_ROPES = WS_ROPEC + 2048 * 32 * 4;
constexpr size_t WS_LB = WS_ROPES + 2048 * 32 * 4;
constexpr size_t WS_KCMP = WS_LB + 512 * 4;
constexpr size_t WS_VCMP = WS_KCMP + 16 * 2 * 128 * 64 * 2;
constexpr size_t WS_W1TK = WS_SMALL + 2 * MiB;
constexpr size_t WS_W1TV = WS_SMALL + 3 * MiB;
constexpr size_t WS_C0 = WS_SMALL + 4 * MiB;
constexpr size_t WS_BAR = WS_SMALL + 4 * MiB + 64 * 1024;
constexpr size_t WS_HBF = 88 * MiB;
constexpr size_t WS_ONSA = WS_HBF;
constexpr size_t WS_OHGRN = WS_HBF + 32 * MiB;
constexpr size_t WS_PA = 152 * MiB;
constexpr size_t WS_PH = 232 * MiB;
constexpr size_t WS_PM = 360 * MiB;
constexpr size_t WS_PG = 488 * MiB;
constexpr size_t WS_YA = 152 * MiB;
constexpr size_t WS_Y = 280 * MiB;
constexpr size_t WS_Q = 152 * MiB;
constexpr size_t WS_X1B = 344 * MiB;
constexpr size_t WS_EXI = 408 * MiB;
constexpr size_t WS_EXW = 424 * MiB;
constexpr size_t WS_SU = WS_U + 16 * MiB;
constexpr size_t WS_SV = WS_V + 16 * MiB;
constexpr size_t WS_SUV = WS_SU + 128 * 1024;
constexpr size_t WS_X8 = 440 * MiB;
constexpr size_t WS_SX = 472 * MiB;
constexpr size_t WS_AOUT = 473 * MiB;
constexpr size_t WS_SSP = 489 * MiB;
constexpr size_t WS_END = 504 * MiB;

constexpr size_t DO_KCC = 0, DO_VCC = 9 * MiB, DO_HID = 20 * MiB, DO_HP = 24 * MiB;
struct Params {
    const float* x; const float* c; const float* w_ada; const float* b_ada; const float* g_mix; const float* g_ffn; const float* w_in;
    const float* cmp_pos_k; const float* cmp_pos_v; const float* w_ck1; const float* w_ck2; const float* w_cv1; const float* w_cv2;
    const float* lb_logits; const float* out_norm; const float* w_branch; const float* w_out; const float* w_peer_q; const float* sub_keys;
    const float* peer_u; const float* peer_v; const float* g_final;
    float* out; unsigned char* ws;
};

__device__ __forceinline__ float bf2f(bf16_t v) { return __uint_as_float((unsigned)v << 16); }
__device__ __forceinline__ bf16_t f2bf(float f) { unsigned u = __float_as_uint(f); u += 0x7fffu + ((u >> 16) & 1u); return (bf16_t)(u >> 16); }
__device__ __forceinline__ unsigned pack2bf(float lo, float hi) { return (unsigned)f2bf(lo) | ((unsigned)f2bf(hi) << 16); }
template <int M> __device__ __forceinline__ float xor_get(float v) { return __int_as_float(__builtin_amdgcn_ds_swizzle(__float_as_int(v), (M << 10) | 0x1f)); }
template <int M> __device__ __forceinline__ unsigned xor_getu(unsigned v) { return (unsigned)__builtin_amdgcn_ds_swizzle((int)v, (M << 10) | 0x1f); }
__device__ __forceinline__ float half_sum(float v) { auto rr = __builtin_amdgcn_permlane32_swap(__float_as_uint(v), __float_as_uint(v), false, false); return __uint_as_float(rr[0]) + __uint_as_float(rr[1]); }
__device__ __forceinline__ float half_max(float v) { auto rr = __builtin_amdgcn_permlane32_swap(__float_as_uint(v), __float_as_uint(v), false, false); return fmaxf(__uint_as_float(rr[0]), __uint_as_float(rr[1])); }
__device__ __forceinline__ float half_other(float v) { auto rr = __builtin_amdgcn_permlane32_swap(__float_as_uint(v), __float_as_uint(v), false, false); return __uint_as_float(rr[0] ^ rr[1] ^ __float_as_uint(v)); }
__device__ __forceinline__ float wave_sum(float v) { v = half_sum(v); v += xor_get<16>(v); v += xor_get<8>(v); v += xor_get<4>(v); v += xor_get<2>(v); v += xor_get<1>(v); return v; }
__device__ __forceinline__ float wave_max(float v) { v = half_max(v); v = fmaxf(v, xor_get<16>(v)); v = fmaxf(v, xor_get<8>(v)); v = fmaxf(v, xor_get<4>(v)); v = fmaxf(v, xor_get<2>(v)); v = fmaxf(v, xor_get<1>(v)); return v; }
__device__ __forceinline__ float sigmoidf_(float x) { return __builtin_amdgcn_rcpf(1.0f + __expf(-x)); }
__device__ __forceinline__ float gelu_tanh(float x) { const float u2 = 1.5957691216057308f * (x + 0.044715f * x * x * x); return x * sigmoidf_(u2); }
__device__ __forceinline__ int fresh_tid() { int w = __builtin_amdgcn_readfirstlane(threadIdx.x >> 6); asm volatile("" : "+s"(w)); int l = __builtin_amdgcn_mbcnt_hi(~0u, __builtin_amdgcn_mbcnt_lo(~0u, 0)); asm volatile("" : "+v"(l)); return w * 64 + l; }
__device__ __forceinline__ void wave_lds_sync() { asm volatile("s_waitcnt lgkmcnt(0)" ::: "memory"); }

namespace pg8 {
typedef short bf16x8 __attribute__((ext_vector_type(8)));
typedef float f32x4 __attribute__((ext_vector_type(4)));
typedef unsigned u32x4 __attribute__((ext_vector_type(4)));
typedef unsigned u32x2 __attribute__((ext_vector_type(2)));
constexpr int BM = 256, BK = 64, HALF = 128, HTB = HALF * BK * 2, STAGE_BYTES = 8 * HTB, NXCD = 8, WGM = 8;
__host__ __device__ __forceinline__ int lds_byte(int r, int c) { const int st = (r >> 4) * 2 + (c >> 5), rr = r & 15, cc = c & 31, ob = rr * 64 + cc * 2; return st * 1024 + (ob ^ (((ob >> 9) & 1) << 5)); }
__host__ __device__ __forceinline__ void stage_rc(int b, int& R, int& C) { const int st = b / 1024, sb = b % 1024, swz = sb ^ (((sb >> 9) & 1) << 5); R = (st >> 1) * 16 + swz / 64; C = (st & 1) * 32 + (swz % 64) / 2; }
__host__ __device__ __forceinline__ int perm32(int rho) { const int n = rho >> 4, i = rho & 15; return 8 * (i >> 2) + 4 * n + (i & 3); }
struct Unit { int pm, pn; };
struct Gemm { const bf16_t* A; const bf16_t* Bt; int M, N, K, lda; };
struct StaticOrder {
    int nM, nN, nwg, G, c;
    __host__ __device__ __forceinline__ void init(int M, int N, int G_, int c_) { nM = M / BM; nN = N / BM; nwg = nM * nN; G = G_; c = c_; }
    __host__ __device__ __forceinline__ bool next(int i, Unit& u) const {
        const long L = (long)i * G + c; if (L >= nwg) return false;
        int wgid = (int)L; { const int q = nwg / NXCD, r = nwg % NXCD, xcd = wgid % NXCD, off = wgid / NXCD; wgid = (xcd < r ? xcd * (q + 1) : r * (q + 1) + (xcd - r) * q) + off; }
        const int nig = WGM * nN, gid = wgid / nig, fm = gid * WGM, gsz = (nM - fm) < WGM ? (nM - fm) : WGM;
        u.pm = fm + ((wgid % nig) % gsz); u.pn = (wgid % nig) / gsz; return true;
    }
    __device__ __forceinline__ void a_ready(const Unit&) const {}
    __device__ __forceinline__ void done(const Unit&) const {}
};
__device__ __forceinline__ unsigned cvt_pk_bf16(float lo, float hi) { unsigned r; asm volatile("v_cvt_pk_bf16_f32 %0, %1, %2" : "=v"(r) : "v"(lo), "v"(hi)); return r; }

struct EpiF32 {
    static constexpr bool PERM = false, AFTER_DRAIN = false;
    float* C; int ldc; int pad_;
    __device__ __forceinline__ void operator()(const f32x4 (&acc)[2][2][4][2], const Unit& u, int wr, int wc, int fr, int fq) const {
        const int row0 = u.pm * BM + wr * 64 + fr, col0 = u.pn * BM + wc * 32 + 4 * fq;
#pragma unroll
        for (int ai = 0; ai < 2; ++ai)
#pragma unroll
            for (int m = 0; m < 4; ++m) { float* rowp = C + (size_t)(row0 + ai * HALF + m * 16) * ldc + col0;
#pragma unroll
                for (int bj = 0; bj < 2; ++bj)
#pragma unroll
                    for (int n = 0; n < 2; ++n) *(f32x4*)(rowp + bj * HALF + n * 16) = acc[ai][bj][m][n]; }
    }
};
__device__ __forceinline__ unsigned pk_f16(float lo, float hi) { typedef _Float16 h2 __attribute__((ext_vector_type(2))); h2 v = {(_Float16)lo, (_Float16)hi}; return __builtin_bit_cast(unsigned, v); }
struct EpiF16 {
    static constexpr bool PERM = true, AFTER_DRAIN = false;
    bf16_t* O; int ntn; int pad_;
    __device__ __forceinline__ void operator()(const f32x4 (&acc)[2][2][4][2], const Unit& u, int wr, int wc, int fr, int fq) const {
        bf16_t* base = O + (size_t)(u.pm * ntn + u.pn) * 65536 + ((wr * 4 + wc) * 1024 + fq * 16 + fr) * 8;
#pragma unroll
        for (int ai = 0; ai < 2; ++ai)
#pragma unroll
            for (int m = 0; m < 4; ++m)
#pragma unroll
                for (int bj = 0; bj < 2; ++bj) { const f32x4 v0 = acc[ai][bj][m][0], v1 = acc[ai][bj][m][1];
                    u32x4 w; w.x = pk_f16(v0[0], v0[1]); w.y = pk_f16(v0[2], v0[3]); w.z = pk_f16(v1[0], v1[1]); w.w = pk_f16(v1[2], v1[3]);
                    *(u32x4*)(base + ((ai * 4 + m) * 2 + bj) * 512) = w; }
    }
};
struct EpiProj {
    static constexpr bool PERM = true, AFTER_DRAIN = false;
    bf16_t* PA; bf16_t* PH; bf16_t* PM; bf16_t* PG; bf16_t* KCc; bf16_t* VCc; const float* rc; const float* rs;
    __device__ __forceinline__ void operator()(const f32x4 (&acc)[2][2][4][2], const Unit& u, int wr, int wc, int fr, int fq) const {
        const int row0 = u.pm * BM + wr * 64 + fr;
        bf16_t* base; int ldc, colt;
        if (u.pn < 5) { base = PA; ldc = 1280; colt = u.pn * 256; }
        else if (u.pn < 13) { base = PH; ldc = 2048; colt = (u.pn - 5) * 256; }
        else if (u.pn < 21) { base = PM; ldc = 2048; colt = (u.pn - 13) * 256; }
        else { base = PG; ldc = 256; colt = 0; }
        const int col0 = colt + wc * 32 + 8 * fq;
        const int i0 = (wc & 1) * 16 + 4 * fq;
#pragma unroll
        for (int ai = 0; ai < 2; ++ai)
#pragma unroll
            for (int m = 0; m < 4; ++m) { const int row = row0 + ai * HALF + m * 16; bf16_t* rowp = base + (size_t)row * ldc + col0; const int t = row & 2047;
#pragma unroll
                for (int bj = 0; bj < 2; ++bj) { f32x4 v0 = acc[ai][bj][m][0], v1 = acc[ai][bj][m][1];
                    const bool rope = (u.pn < 2) || (u.pn < 5 && bj == 0);
                    if (rope) { const f32x4 c = *(const f32x4*)(rc + t * 32 + i0), sn = *(const f32x4*)(rs + t * 32 + i0);
                        const f32x4 a0 = v0, a1 = v1;
                        v0[0] = a0[0] * c[0] - a0[1] * sn[0]; v0[1] = a0[1] * c[0] + a0[0] * sn[0]; v0[2] = a0[2] * c[1] - a0[3] * sn[1]; v0[3] = a0[3] * c[1] + a0[2] * sn[1];
                        v1[0] = a1[0] * c[2] - a1[1] * sn[2]; v1[1] = a1[1] * c[2] + a1[0] * sn[2]; v1[2] = a1[2] * c[3] - a1[3] * sn[3]; v1[3] = a1[3] * c[3] + a1[2] * sn[3]; }
                    if (u.pn >= 13 && u.pn < 21) {
#pragma unroll
                        for (int q = 0; q < 4; ++q) { v0[q] = sigmoidf_(v0[q]); v1[q] = sigmoidf_(v1[q]); } }
                    if (u.pn >= 13 && u.pn < 21) {
                        unsigned q_[8];
#pragma unroll
                        for (int e = 0; e < 4; ++e) { q_[e] = (unsigned)fmaxf(rintf(v0[e] * 255.0f), 1.0f); q_[4 + e] = (unsigned)fmaxf(rintf(v1[e] * 255.0f), 1.0f); }
                        u32x2 w8; w8.x = q_[0] | (q_[1] << 8) | (q_[2] << 16) | (q_[3] << 24); w8.y = q_[4] | (q_[5] << 8) | (q_[6] << 16) | (q_[7] << 24);
                        *(u32x2*)((unsigned char*)PM + (size_t)(u.pm * 8 + (u.pn - 13)) * 65536 + (size_t)(wr * 4 + wc) * 8192 + (((ai * 4 + m) * 2 + bj) * 64 + fq * 16 + fr) * 8) = w8;
                        continue; }
                    u32x4 w; w.x = cvt_pk_bf16(v0[0], v0[1]); w.y = cvt_pk_bf16(v0[2], v0[3]); w.z = cvt_pk_bf16(v1[0], v1[1]); w.w = cvt_pk_bf16(v1[2], v1[3]);
                    if (u.pn >= 5 && u.pn < 13) { bf16_t* tb = PH + (size_t)(u.pm * 8 + (u.pn - 5)) * 65536;
                        *(u32x4*)(tb + (size_t)(wr * 4 + wc) * 8192 + (((ai * 4 + m) * 2 + bj) * 64 + fq * 16 + fr) * 8) = w; }
                    else if (u.pn == 2) { bf16_t* cb = bj ? VCc : KCc; *(u32x4*)(cb + ((size_t)((row >> 11) * 2 + (wc >> 1)) * 2048 + t) * 64 + (wc & 1) * 32 + 8 * fq) = w; }
                    else *(u32x4*)(rowp + bj * HALF) = w; } }
    }
};
struct EpiCompress {
    static constexpr bool PERM = false, AFTER_DRAIN = false;
    bf16_t* HID; const float* c0;
    __device__ __forceinline__ void operator()(const f32x4 (&acc)[2][2][4][2], const Unit& u, int wr, int wc, int fr, int fq) const {
        const int row0 = u.pm * BM + wr * 64 + fr, col0 = wc * 32 + 4 * fq;
#pragma unroll
        for (int ai = 0; ai < 2; ++ai)
#pragma unroll
            for (int m = 0; m < 4; ++m) { const size_t row = (size_t)(row0 + ai * HALF + m * 16);
#pragma unroll
                for (int bj = 0; bj < 2; ++bj)
#pragma unroll
                    for (int n = 0; n < 2; ++n) { const int col = bj * HALF + col0 + n * 16; const f32x4 a = acc[ai][bj][m][n];
                        u32x2 w; w.x = cvt_pk_bf16(a[0], a[1]); w.y = cvt_pk_bf16(a[2], a[3]);
                        *(u32x2*)(HID + row * 256 + col) = w; } }
    }
};
struct EpiBranch {
    static constexpr bool PERM = true, AFTER_DRAIN = false, HAS_MID = true; static constexpr int MID_T = 8;
    const bf16_t* PM; bf16_t* Y;
    __device__ __forceinline__ void mid(f32x4 (&acc)[2][2][4][2], const Unit& u, int wr, int wc, int fr, int fq) const {
        int lo = ((wr * 4 + wc) * 1024 + fq * 16 + fr) * 8;
        asm volatile("" : "+v"(lo));
        const unsigned char* pa = (const unsigned char*)PM + (size_t)(u.pm * 8 + u.pn) * 65536 + lo; const unsigned char* pb = pa + 4 * 65536;
#pragma unroll
        for (int ai = 0; ai < 2; ++ai) {
#pragma unroll
            for (int m = 0; m < 4; ++m) {
#pragma unroll
                for (int bj = 0; bj < 2; ++bj) { const int k = (ai * 4 + m) * 2 + bj; const u32x2 ga = *(const u32x2*)(pa + k * 512), gb = *(const u32x2*)(pb + k * 512);
#pragma unroll
                    for (int w = 0; w < 2; ++w)
#pragma unroll
                        for (int e = 0; e < 4; ++e) acc[ai][bj][m][w][e] *= (float)((ga[w] >> (8 * e)) & 0xffu) * __builtin_amdgcn_rcpf((float)((gb[w] >> (8 * e)) & 0xffu)); }
            }
            asm volatile("" ::: "memory"); }
    }
    __device__ __forceinline__ void operator()(const f32x4 (&acc)[2][2][4][2], const Unit& u, int wr, int wc, int fr, int fq) const {
        const int row0 = u.pm * BM + wr * 64 + fr, col0 = u.pn * BM + wc * 32 + 8 * fq;
        const unsigned char* pb = (const unsigned char*)PM + (size_t)(u.pm * 8 + 4 + u.pn) * 65536 + ((wr * 4 + wc) * 1024 + fq * 16 + fr) * 8;
#pragma unroll
        for (int ai = 0; ai < 2; ++ai)
#pragma unroll
            for (int m = 0; m < 4; ++m) { const size_t row = (size_t)(row0 + ai * HALF + m * 16);
#pragma unroll
                for (int bj = 0; bj < 2; ++bj) { const u32x2 gb = *(const u32x2*)(pb + ((ai * 4 + m) * 2 + bj) * 512); const f32x4 v0 = acc[ai][bj][m][0], v1 = acc[ai][bj][m][1];
                    constexpr float S8 = 1.0f / 255.0f;
                    u32x4 w;
                    w.x = cvt_pk_bf16(v0[0] * ((float)(gb[0] & 0xffu) * S8), v0[1] * ((float)((gb[0] >> 8) & 0xffu) * S8));
                    w.y = cvt_pk_bf16(v0[2] * ((float)((gb[0] >> 16) & 0xffu) * S8), v0[3] * ((float)(gb[0] >> 24) * S8));
                    w.z = cvt_pk_bf16(v1[0] * ((float)(gb[1] & 0xffu) * S8), v1[1] * ((float)((gb[1] >> 8) & 0xffu) * S8));
                    w.w = cvt_pk_bf16(v1[2] * ((float)((gb[1] >> 16) & 0xffu) * S8), v1[3] * ((float)(gb[1] >> 24) * S8));
                    *(u32x4*)(Y + row * 1024 + col0 + bj * HALF) = w; } }
    }
};
struct EpiResid {
    static constexpr bool PERM = true, AFTER_DRAIN = false;
    const float* X; const float* mod; bf16_t* X1;
    __device__ __forceinline__ void operator()(const f32x4 (&acc)[2][2][4][2], const Unit& u, int wr, int wc, int fr, int fq) const {
        const int row0 = u.pm * BM + wr * 64 + fr, col0 = u.pn * BM + wc * 32 + 8 * fq;
        const int b = (u.pm * BM) >> 11;
#pragma unroll
        for (int ai = 0; ai < 2; ++ai)
#pragma unroll
            for (int m = 0; m < 4; ++m) { const size_t row = (size_t)(row0 + ai * HALF + m * 16);
#pragma unroll
                for (int bj = 0; bj < 2; ++bj) { const int col = col0 + bj * HALF;
                    const f32x4 g0 = *(const f32x4*)(mod + b * 6144 + 2048 + col), g1 = *(const f32x4*)(mod + b * 6144 + 2048 + col + 4);
                    const f32x4 x0 = *(const f32x4*)(X + row * 1024 + col), x1 = *(const f32x4*)(X + row * 1024 + col + 4);
                    const f32x4 r0 = x0 + g0 * acc[ai][bj][m][0], r1 = x1 + g1 * acc[ai][bj][m][1];
                    u32x4 w; w.x = cvt_pk_bf16(r0[0], r0[1]); w.y = cvt_pk_bf16(r0[2], r0[3]); w.z = cvt_pk_bf16(r1[0], r1[1]); w.w = cvt_pk_bf16(r1[2], r1[3]);
                    *(u32x4*)(X1 + row * 1024 + col) = w; } }
    }
};
template <class E_, class = void> struct mid_hook { static constexpr bool value = false; };
template <class E_> struct mid_hook<E_, decltype((void)E_::HAS_MID)> { static constexpr bool value = E_::HAS_MID; };
template <class Epi, class Sched>
__device__ __forceinline__ void gemm_phase(LAS unsigned char* lds, const Gemm g, const Sched& S, const Epi& E) {
    const int tidx = fresh_tid();
    const int tid = tidx, wid = __builtin_amdgcn_readfirstlane(tid >> 6), lane = tid & 63, wr = wid >> 2, wc = wid & 3, fr = lane & 15, fq = lane >> 4;
    const int K = g.K, nt = K / BK;
    unsigned voffA[2], voffB[2];
#pragma unroll
    for (int i = 0; i < 2; ++i) { int R, C; stage_rc(tid * 16 + i * 8192, R, C); const int Rb = Epi::PERM ? ((R & ~31) + perm32(R & 31)) : R;
        voffA[i] = (unsigned)(R * g.lda + C) * 2u; voffB[i] = (unsigned)(Rb * K + C) * 2u; }
    const size_t kstep = (size_t)(BK * 2);
    const size_t hstep = (size_t)HALF * K * 2, hstepA = (size_t)HALF * g.lda * 2;
    const size_t tstep = 2 * hstep, tstepA = 2 * hstepA;
    const unsigned ldsw = (unsigned)wid * 1024u;
    const int aoff = lds_byte(wr * 64 + fr, fq * 8), boff = lds_byte(wc * 32 + fr, fq * 8);
#define PG8_SA(b, h) (((b) * 2 + (h)) * HTB)
#define PG8_SB(b, h) ((4 + (b) * 2 + (h)) * HTB)
#define PG8_STAGE(bufoff, gbase, voff) do { _Pragma("unroll") for (int _i = 0; _i < 2; ++_i) \
        __builtin_amdgcn_global_load_lds((const unsigned*)((const char*)(gbase) + (voff)[_i]), (LAS unsigned*)(lds + (bufoff) + ldsw + _i * 8192), 16, 0, 0); } while (0)
#define PG8_LDA(dst, b, h) do { _Pragma("unroll") for (int m = 0; m < 4; ++m) _Pragma("unroll") for (int k = 0; k < 2; ++k) dst[m][k] = *(const LAS bf16x8*)(lds + PG8_SA(b, h) + aoff + m * 2048 + k * 1024); } while (0)
#define PG8_LDB(dst, b, h) do { _Pragma("unroll") for (int n = 0; n < 2; ++n) _Pragma("unroll") for (int k = 0; k < 2; ++k) dst[n][k] = *(const LAS bf16x8*)(lds + PG8_SB(b, h) + boff + n * 2048 + k * 1024); } while (0)
#define PG8_MMA(ai, bj, At, Bt) do { __builtin_amdgcn_s_setprio(1); _Pragma("unroll") for (int m = 0; m < 4; ++m) _Pragma("unroll") for (int n = 0; n < 2; ++n) _Pragma("unroll") for (int k = 0; k < 2; ++k) \
        acc[ai][bj][m][n] = __builtin_amdgcn_mfma_f32_16x16x32_bf16(Bt[n][k], At[m][k], acc[ai][bj][m][n], 0, 0, 0); __builtin_amdgcn_s_setprio(0); } while (0)
#define PG8_WAIT_V(n) asm volatile("s_waitcnt vmcnt(" #n ")" ::: "memory")
#define PG8_WAIT_L(n) asm volatile("s_waitcnt lgkmcnt(" #n ")" ::: "memory")
#define PG8_BAR __builtin_amdgcn_s_barrier()
#define PG8_SCHED __builtin_amdgcn_sched_barrier(0)
    Unit cur, nxt; int ui = 0;
    if (!S.next(0, cur)) return;
    f32x4 acc[2][2][4][2];
#pragma unroll
    for (int a = 0; a < 2; ++a)
#pragma unroll
        for (int b = 0; b < 2; ++b)
#pragma unroll
            for (int m = 0; m < 4; ++m)
#pragma unroll
                for (int n = 0; n < 2; ++n) acc[a][b][m][n] = (f32x4){0.f, 0.f, 0.f, 0.f};
    bf16x8 At[4][2], B0[2][2], B1[2][2];
    const char* cA = (const char*)g.A + (size_t)cur.pm * tstepA; const char* cB = (const char*)g.Bt + (size_t)cur.pn * tstep;
    S.a_ready(cur);
    PG8_STAGE(PG8_SB(0, 0), cB, voffB); PG8_STAGE(PG8_SB(0, 1), cB + hstep, voffB); PG8_STAGE(PG8_SA(0, 0), cA, voffA); PG8_STAGE(PG8_SA(0, 1), cA + hstepA, voffA);
    if (wr == 1) PG8_BAR;
    PG8_WAIT_V(2); PG8_BAR;
    PG8_STAGE(PG8_SB(1, 0), cB + kstep, voffB); PG8_STAGE(PG8_SA(1, 0), cA + kstep, voffA); PG8_STAGE(PG8_SB(1, 1), cB + hstep + kstep, voffB);
    PG8_WAIT_V(6); PG8_BAR;
    for (;;) {
        const bool has_next = S.next(ui + 1, nxt);
        const char* nA = has_next ? (const char*)g.A + (size_t)nxt.pm * tstepA : cA; const char* nB = has_next ? (const char*)g.Bt + (size_t)nxt.pn * tstep : cB;
        for (int t = 0; t < nt; t += 2) {
            const bool last = (t == nt - 2);
            const char* a1 = cA + (size_t)(t + 1) * kstep;
            const char* a2 = last ? nA : cA + (size_t)(t + 2) * kstep; const char* b2 = last ? nB : cB + (size_t)(t + 2) * kstep;
            const char* a3 = a2 + kstep; const char* b3 = b2 + kstep;
            if (last && has_next) S.a_ready(nxt);
            if constexpr (mid_hook<Epi>::value) { if (t == Epi::MID_T) E.mid(acc, cur, wr, wc, fr, fq); }
            PG8_LDB(B0, 0, 0); PG8_LDB(B1, 0, 1); PG8_SCHED; PG8_LDA(At, 0, 0); PG8_STAGE(PG8_SA(1, 1), a1 + hstepA, voffA);
            PG8_WAIT_V(8); PG8_WAIT_L(0); PG8_BAR; PG8_MMA(0, 0, At, B0); PG8_MMA(0, 1, At, B1); PG8_BAR; PG8_SCHED;
            PG8_LDA(At, 0, 1); PG8_STAGE(PG8_SB(0, 0), b2, voffB); PG8_STAGE(PG8_SB(0, 1), b2 + hstep, voffB); PG8_STAGE(PG8_SA(0, 0), a2, voffA);
            PG8_WAIT_V(8); PG8_WAIT_L(0); PG8_BAR; PG8_MMA(1, 0, At, B0); PG8_MMA(1, 1, At, B1); PG8_BAR; PG8_SCHED;
            PG8_LDB(B0, 1, 0); PG8_LDB(B1, 1, 1); PG8_SCHED; PG8_LDA(At, 1, 0); PG8_STAGE(PG8_SA(0, 1), a2 + hstepA, voffA);
            PG8_WAIT_V(8); PG8_WAIT_L(0); PG8_BAR; PG8_MMA(0, 0, At, B0); PG8_MMA(0, 1, At, B1); PG8_BAR; PG8_SCHED;
            PG8_LDA(At, 1, 1); PG8_STAGE(PG8_SB(1, 0), b3, voffB); PG8_STAGE(PG8_SB(1, 1), b3 + hstep, voffB); PG8_STAGE(PG8_SA(1, 0), a3, voffA);
            PG8_WAIT_V(8); PG8_WAIT_L(0); PG8_BAR; PG8_MMA(1, 0, At, B0); PG8_MMA(1, 1, At, B1); PG8_BAR; PG8_SCHED;
        }
        if (wr == 0) PG8_BAR;
        E(acc, cur, wr, wc, fr, fq); S.done(cur);
        if (!has_next) break;
#pragma unroll
        for (int a = 0; a < 2; ++a)
#pragma unroll
            for (int b = 0; b < 2; ++b)
#pragma unroll
                for (int m = 0; m < 4; ++m)
#pragma unroll
                    for (int n = 0; n < 2; ++n) acc[a][b][m][n] = (f32x4){0.f, 0.f, 0.f, 0.f};
        cur = nxt; cA = nA; cB = nB; ++ui;
        if (wr == 1) PG8_BAR;
    }
    PG8_WAIT_V(0);
    PG8_BAR;
#undef PG8_SA
#undef PG8_SB
#undef PG8_STAGE
#undef PG8_LDA
#undef PG8_LDB
#undef PG8_MMA
#undef PG8_WAIT_V
#undef PG8_WAIT_L
#undef PG8_BAR
#undef PG8_SCHED
}
}

__device__ __forceinline__ int proj_src_col(int c) {
    if (c < 1280) return c;
    if (c < 5376) return c + 24;
    if (c < 5400) return 1280 + (c - 5376);
    return -1;
}
__device__ __forceinline__ int pair_dim(int c) { return (c >> 1) + 32 * (c & 1); }
struct MapIdent { __device__ __forceinline__ int operator()(int n) const { return n; } };
struct MapProj { __device__ __forceinline__ int operator()(int n) const {
    const bool roped = (n < 640) || (n >= 768 && n < 896) || (n >= 1024 && n < 1152);
    return proj_src_col(roped ? (n & ~63) + pair_dim(n & 63) : n); } };
struct Map128 { __device__ __forceinline__ int operator()(int n) const { return n < 128 ? n : -1; } };
struct RowPair { __device__ __forceinline__ int operator()(int k) const { return (k & ~63) + pair_dim(k & 63); } };
template <class Map, class RMap> __device__ __forceinline__ void prep_transpose(const float* src, int K, int ldsrc, bf16_t* dst, int Nrows, Map map, RMap rmap, float* tile) {
    const int tidx = fresh_tid();
    const int tid = tidx, r = tid >> 6, c = tid & 63, nkt = K >> 6, nit = nkt * (Nrows >> 6);
    if ((int)blockIdx.x >= nit) return;
    float nx[8];
    auto ldtile = [&](int item) __attribute__((always_inline)) { const int nt = item / nkt, kt = item - nt * nkt, n0 = nt * 64, k0 = kt * 64; const int sc = map(n0 + c);
#pragma unroll
        for (int ps = 0; ps < 8; ++ps) { const int kk = ps * 8 + r; nx[ps] = src[(size_t)rmap(k0 + kk) * ldsrc + (sc >= 0 ? sc : 0)]; } };
    ldtile(blockIdx.x);
    for (int item = blockIdx.x; item < nit; item += gridDim.x) {
        const int nt = item / nkt, kt = item - nt * nkt, n0 = nt * 64, k0 = kt * 64; const int sc = map(n0 + c);
        float cur[8];
#pragma unroll
        for (int ps = 0; ps < 8; ++ps) cur[ps] = nx[ps];
        ldtile(min(item + (int)gridDim.x, nit - 1));
#pragma unroll
        for (int ps = 0; ps < 8; ++ps) { const int kk = ps * 8 + r; tile[kk * 65 + c] = sc >= 0 ? cur[ps] : 0.f; }
        __syncthreads();
        { const int nn = tid >> 3, kg = tid & 7;
          unsigned w_[4];
#pragma unroll
          for (int q = 0; q < 4; ++q) w_[q] = (unsigned)f2bf(tile[(8 * kg + 2 * q) * 65 + nn]) | ((unsigned)f2bf(tile[(8 * kg + 2 * q + 1) * 65 + nn]) << 16);
          *(uint4*)(dst + (size_t)(n0 + nn) * K + k0 + 8 * kg) = make_uint4(w_[0], w_[1], w_[2], w_[3]); }
        __syncthreads();
    }
}
__device__ __forceinline__ void ph_prep(const Params& p, float* sm) {
    const int tidx = fresh_tid();
    const int tid = tidx, gtid = blockIdx.x * blockDim.x + tidx, gsz = gridDim.x * blockDim.x;
    unsigned char* ws = p.ws;
    float* rc = (float*)(ws + WS_ROPEC); float* rs = (float*)(ws + WS_ROPES); float* lb = (float*)(ws + WS_LB); float* mod = (float*)(ws + WS_MOD);
    for (int i = gtid; i < 2048 * 32; i += gsz) {
        const int t = i >> 5, k = i & 31;
        const float inv = exp2f(-(float)k * (13.287712379549449f / 32.0f));
        const float ang = (float)t * inv;
        const double a = (double)ang; const double n = rint(a * 0.15915494309189535); const float r = (float)(a - n * 6.283185307179586);
        rc[i] = cosf(r); rs[i] = sinf(r);
    }
    for (int i = gtid; i < 512; i += gsz) { const float a = p.lb_logits[i], b = p.lb_logits[512 + i]; const float m = fmaxf(a, b); const float ea = expf(a - m), eb = expf(b - m); lb[i] = ea / (ea + eb); }
    if (blockIdx.x < 192) {
        float* cs = sm; float* red = sm + 16384;
        for (int i = tid; i < 16384; i += 512) { const float c = p.c[i]; cs[i] = c / (1.0f + expf(-c)); }
        __syncthreads();
        for (int item = blockIdx.x; item < 192; item += gridDim.x) {
            const int j0 = item * 32, kq = tid >> 5, jj = tid & 31;
            float acc[16];
#pragma unroll
            for (int b = 0; b < 16; ++b) acc[b] = 0.f;
            float wv[8];
#pragma unroll
            for (int q = 0; q < 8; ++q) wv[q] = p.w_ada[(size_t)(kq * 64 + q) * 6144 + j0 + jj];
            for (int kk0 = 0; kk0 < 64; kk0 += 8) {
#pragma unroll
                for (int q = 0; q < 8; ++q) { const int k = kq * 64 + kk0 + q; const float w = wv[q];
                    wv[q] = p.w_ada[(size_t)(kq * 64 + min(kk0 + q + 8, 63)) * 6144 + j0 + jj];
#pragma unroll
                    for (int b = 0; b < 16; ++b) acc[b] += cs[b * 1024 + k] * w; } }
#pragma unroll
            for (int b = 0; b < 16; ++b) red[(kq * 16 + b) * 32 + jj] = acc[b];
            __syncthreads();
            { const int b = tid >> 5; float sacc = 0.f;
#pragma unroll
              for (int q = 0; q < 16; ++q) sacc += red[(q * 16 + b) * 32 + jj];
              mod[b * 6144 + j0 + jj] = sacc + p.b_ada[j0 + jj]; }
            __syncthreads();
        }
    }
    __syncthreads();
    prep_transpose(p.w_in, 1024, IN_COLS, (bf16_t*)(ws + WS_WIN), NPROJ, MapProj(), MapIdent(), sm);
    prep_transpose(p.w_branch, 1024, 1024, (bf16_t*)(ws + WS_WB), 1024, MapIdent(), MapIdent(), sm);
    prep_transpose(p.w_out, 1024, 1024, (bf16_t*)(ws + WS_WOUT), 1024, MapIdent(), MapIdent(), sm);
    prep_transpose(p.w_ck1, 1024, 128, (bf16_t*)(ws + WS_W1TK), 128, MapIdent(), RowPair(), sm);
    prep_transpose(p.w_ck1 + 1024 * 128, 1024, 128, (bf16_t*)(ws + WS_W1TK) + 128 * 1024, 128, MapIdent(), RowPair(), sm);
    prep_transpose(p.w_cv1, 1024, 128, (bf16_t*)(ws + WS_W1TV), 128, MapIdent(), MapIdent(), sm);
    prep_transpose(p.w_cv1 + 1024 * 128, 1024, 128, (bf16_t*)(ws + WS_W1TV) + 128 * 1024, 128, MapIdent(), MapIdent(), sm);
    for (int item = blockIdx.x; item < 256; item += gridDim.x) {
        const int which = item >> 7, j = item & 127; const float* pe = which ? p.cmp_pos_v : p.cmp_pos_k; const float* w1 = which ? p.w_cv1 : p.w_ck1;
        float a = 0.f;
#pragma unroll
        for (int q = 0; q < 4; ++q) { const int i = tid + 512 * q; a += pe[i] * w1[(size_t)i * 128 + j]; }
        a = wave_sum(a);
        __syncthreads();
        if ((tid & 63) == 0) sm[tid >> 6] = a;
        __syncthreads();
        if (tid == 0) ((float*)(ws + WS_C0))[item] = ((sm[0] + sm[1]) + (sm[2] + sm[3])) + ((sm[4] + sm[5]) + (sm[6] + sm[7]));
    }
    __syncthreads();
    {
        typedef float f32x4p __attribute__((ext_vector_type(4)));
        float* sk = sm; float* wq = sm + 128 * 132; bf16_t* dst = (bf16_t*)(ws + WS_WQ);
        for (int item = blockIdx.x; item < 256; item += gridDim.x) {
            const int hp = item >> 4, c0 = (item & 15) * 64, h = hp >> 1, pp = hp & 1;
            { float4 fs[8], fw[4];
#pragma unroll
              for (int q = 0; q < 8; ++q) { const int i = tid + 512 * q, k = i >> 5, d4 = i & 31; fs[q] = *(const float4*)(p.sub_keys + (((size_t)pp * 8 + h) * 128 + k) * 128 + 4 * d4); }
#pragma unroll
              for (int q = 0; q < 4; ++q) { const int i = tid + 512 * q, c = i >> 5, d4 = i & 31; fw[q] = *(const float4*)(p.w_peer_q + (size_t)(c0 + c) * 2048 + h * 256 + pp * 128 + 4 * d4); }
#pragma unroll
              for (int q = 0; q < 8; ++q) { const int i = tid + 512 * q, k = i >> 5, d4 = i & 31; *(float4*)(sk + k * 132 + 4 * d4) = fs[q]; }
#pragma unroll
              for (int q = 0; q < 4; ++q) { const int i = tid + 512 * q, c = i >> 5, d4 = i & 31; *(float4*)(wq + c * 132 + 4 * d4) = fw[q]; } }
            __syncthreads();
            const int lane = tid & 63, nt = tid >> 6, l15 = lane & 15, g4 = lane >> 4;
            f32x4p acc[4];
#pragma unroll
            for (int ct = 0; ct < 4; ++ct) acc[ct] = (f32x4p){0.f, 0.f, 0.f, 0.f};
            const float* ap = sk + (16 * nt + l15) * 132 + g4; const float* bp = wq + l15 * 132 + g4;
#pragma unroll 8
            for (int d0 = 0; d0 < 128; d0 += 4) { const float av = ap[d0];
#pragma unroll
                for (int ct = 0; ct < 4; ++ct) acc[ct] = __builtin_amdgcn_mfma_f32_16x16x4f32(av, bp[ct * 16 * 132 + d0], acc[ct], 0, 0, 0); }
#pragma unroll
            for (int ct = 0; ct < 4; ++ct)
#pragma unroll
                for (int r = 0; r < 4; ++r) dst[(size_t)(hp * 128 + 16 * nt + 4 * g4 + r) * 1024 + c0 + 16 * ct + l15] = f2bf(acc[ct][r]);
            __syncthreads();
        }
    }
    { const int wave = tid >> 6, lane = tid & 63;
      float4 nv0, nv1, nv2, nv3;
      { const int r0 = blockIdx.x * 8 + wave; const float4* s0 = (const float4*)(((r0 >> 14) ? p.peer_v : p.peer_u) + (size_t)(r0 & 16383) * 1024); nv0 = s0[lane]; nv1 = s0[lane + 64]; nv2 = s0[lane + 128]; nv3 = s0[lane + 192]; }
      for (int row = blockIdx.x * 8 + wave; row < 32768; row += gridDim.x * 8) {
        const int which = row >> 14, e = row & 16383;
        float4 v[4] = {nv0, nv1, nv2, nv3}; float amax = 0.f;
        { const int rn = row + gridDim.x * 8; if (rn < 32768) { const float4* s1 = (const float4*)(((rn >> 14) ? p.peer_v : p.peer_u) + (size_t)(rn & 16383) * 1024); nv0 = s1[lane]; nv1 = s1[lane + 64]; nv2 = s1[lane + 128]; nv3 = s1[lane + 192]; } }
#pragma unroll
        for (int i = 0; i < 4; ++i) amax = fmaxf(amax, fmaxf(fmaxf(fabsf(v[i].x), fabsf(v[i].y)), fmaxf(fabsf(v[i].z), fabsf(v[i].w))));
        amax = wave_max(amax);
        const float inv = amax > 0.f ? 127.0f / amax : 0.f; const int off = which ? 128 : 0;
        unsigned* dst = (unsigned*)(ws + (which ? WS_V : WS_U) + (size_t)e * 1024);
#pragma unroll
        for (int i = 0; i < 4; ++i) {
            const int q0 = (int)rintf(v[i].x * inv) + off, q1 = (int)rintf(v[i].y * inv) + off, q2 = (int)rintf(v[i].z * inv) + off, q3 = (int)rintf(v[i].w * inv) + off;
            const unsigned wq_ = (unsigned)(q0 & 255) | ((unsigned)(q1 & 255) << 8) | ((unsigned)(q2 & 255) << 16) | ((unsigned)(q3 & 255) << 24);
            if (which) { const int cw = lane + 64 * i;
                ((unsigned*)(ws + WS_V))[(size_t)(cw >> 5) * (16384 * 32) + (size_t)e * 32 + (cw & 31)] = wq_; }
            else dst[lane + 64 * i] = wq_; }
        if (lane == 0) { ((float*)(ws + (which ? WS_SV : WS_SU)))[e] = amax * (1.0f / 127.0f); ((float*)(ws + WS_SUV))[2 * e + which] = amax * (1.0f / 127.0f); }
      } }
}

template <bool BF16IN> __device__ __forceinline__ void ph_rmsnorm_mod(const void* xin, const float* g, const float* mod, int sh_off, int sc_off, bf16_t* out, unsigned* x8, float* sx) {
    const int tidx = fresh_tid();
    const int wave = tidx >> 6, lane = tidx & 63, wpb = blockDim.x >> 6;
    constexpr int D = 4;
    const int nw = gridDim.x * wpb, gw = blockIdx.x * wpb + wave;
    const int rpw = (NTOK + nw - 1) / nw, rbeg = gw * rpw, rend = min(rbeg + rpw, NTOK);
    if (rbeg >= rend) return;
    float4 nf[D][4]; uint2 nb[D][4];
#pragma unroll
    for (int k = 0; k < D; ++k) { const int r0 = min(rbeg + k, rend - 1);
#pragma unroll
      for (int i = 0; i < 4; ++i) { if (BF16IN) nb[k][i] = ((const uint2*)((const bf16_t*)xin + (size_t)r0 * 1024))[lane + 64 * i]; else nf[k][i] = ((const float4*)((const float*)xin + (size_t)r0 * 1024))[lane + 64 * i]; } }
    int bcur = -1; float4 ga[4], shv[4];
    for (int row0 = rbeg; row0 < rend; row0 += D) {
#pragma unroll
      for (int k = 0; k < D; ++k) {
        const bool live = row0 + k < rend; const int row = min(row0 + k, rend - 1);
        if ((row >> 11) != bcur) { bcur = row >> 11; const float* mb = mod + bcur * 6144;
#pragma unroll
            for (int i = 0; i < 4; ++i) { const int col = (lane + 64 * i) * 4; const float4 gg = *(const float4*)(g + col), sc = *(const float4*)(mb + sc_off + col); shv[i] = *(const float4*)(mb + sh_off + col);
                ga[i] = make_float4(gg.x * (1.0f + sc.x), gg.y * (1.0f + sc.y), gg.z * (1.0f + sc.z), gg.w * (1.0f + sc.w)); } }
        float4 v[4]; float ss = 0.f;
#pragma unroll
        for (int i = 0; i < 4; ++i) {
            if (BF16IN) v[i] = make_float4(__uint_as_float(nb[k][i].x << 16), __uint_as_float(nb[k][i].x & 0xffff0000u), __uint_as_float(nb[k][i].y << 16), __uint_as_float(nb[k][i].y & 0xffff0000u));
            else v[i] = nf[k][i];
            ss += v[i].x * v[i].x + v[i].y * v[i].y + v[i].z * v[i].z + v[i].w * v[i].w; }
        { const int rn = min(row + D, rend - 1);
#pragma unroll
          for (int i = 0; i < 4; ++i) { if (BF16IN) nb[k][i] = ((const uint2*)((const bf16_t*)xin + (size_t)rn * 1024))[lane + 64 * i]; else nf[k][i] = ((const float4*)((const float*)xin + (size_t)rn * 1024))[lane + 64 * i]; } }
        ss = wave_sum(ss);
        const float rstd = rsqrtf(ss * (1.0f / 1024.0f) + 1e-6f);
#pragma unroll
        for (int i = 0; i < 4; ++i) {
            const int col = (lane + 64 * i) * 4;
            const float o0 = v[i].x * rstd * ga[i].x + shv[i].x, o1 = v[i].y * rstd * ga[i].y + shv[i].y;
            const float o2 = v[i].z * rstd * ga[i].z + shv[i].z, o3 = v[i].w * rstd * ga[i].w + shv[i].w;
            if (live) *(uint2*)(out + (size_t)row * 1024 + col) = make_uint2(pack2bf(o0, o1), pack2bf(o2, o3));
            v[i] = make_float4(o0, o1, o2, o3);
        }
        if (x8 && live) {
            float amax = 0.f;
#pragma unroll
            for (int i = 0; i < 4; ++i) amax = fmaxf(amax, fmaxf(fmaxf(fabsf(v[i].x), fabsf(v[i].y)), fmaxf(fabsf(v[i].z), fabsf(v[i].w))));
            amax = wave_max(amax); const float inv = amax > 0.f ? 127.0f / amax : 0.f;
#pragma unroll
            for (int i = 0; i < 4; ++i) { const int q0 = (int)rintf(v[i].x * inv), q1 = (int)rintf(v[i].y * inv), q2 = (int)rintf(v[i].z * inv), q3 = (int)rintf(v[i].w * inv);
                x8[(size_t)row * 256 + lane + 64 * i] = (unsigned)(q0 & 255) | ((unsigned)(q1 & 255) << 8) | ((unsigned)(q2 & 255) << 16) | ((unsigned)(q3 & 255) << 24); }
            if (lane == 0) sx[row] = amax * (1.0f / 127.0f);
        }
      }
    }
}

__device__ __forceinline__ void compress_stage2(const bf16_t* HID, const float* c0, const float* w2, bf16_t* dst, int pm, bool pairperm, float* w2s) {
    typedef short bf16x8_ __attribute__((ext_vector_type(8))); typedef float f32x4_ __attribute__((ext_vector_type(4)));
    const int tidx = fresh_tid();
    const int lane = tidx & 63, l15 = lane & 15, g = lane >> 4, wid = tidx >> 6;
    bf16_t* w2t = (bf16_t*)w2s;
    __syncthreads();
    for (int i = tidx; i < 128 * 64; i += 512) { const int j = i >> 6, c = i & 63; w2t[c * 136 + j] = f2bf(w2[j * 64 + (pairperm ? pair_dim(c) : c)]); }
    asm volatile("s_waitcnt vmcnt(0)" ::: "memory");
    __syncthreads();
    f32x4_ acc[2][4];
#pragma unroll
    for (int mt = 0; mt < 2; ++mt)
#pragma unroll
        for (int nt = 0; nt < 4; ++nt) acc[mt][nt] = (f32x4_){0.f, 0.f, 0.f, 0.f};
    const int row0 = pm * 256 + wid * 32;
#pragma unroll
    for (int ks = 0; ks < 4; ++ks) {
        bf16x8_ af[2], bfr[4];
#pragma unroll
        for (int mt = 0; mt < 2; ++mt) {
            const size_t row = (size_t)(row0 + 16 * mt + l15); const int kc = 32 * ks + 8 * g;
            const pg8::u32x4 uu = *(const pg8::u32x4*)(HID + row * 256 + kc), ll = *(const pg8::u32x4*)(HID + (row + 1) * 256 + 128 + kc);
            const pg8::f32x4 ca = *(const pg8::f32x4*)(c0 + kc), cb = *(const pg8::f32x4*)(c0 + kc + 4);
            const float cc[8] = {ca[0], ca[1], ca[2], ca[3], cb[0], cb[1], cb[2], cb[3]};
            pg8::u32x4 hw;
#pragma unroll
            for (int q = 0; q < 4; ++q) { const float h0 = __uint_as_float(uu[q] << 16) + __uint_as_float(ll[q] << 16) + cc[2 * q], h1 = __uint_as_float(uu[q] & 0xffff0000u) + __uint_as_float(ll[q] & 0xffff0000u) + cc[2 * q + 1];
                hw[q] = pg8::cvt_pk_bf16(gelu_tanh(h0), gelu_tanh(h1)); }
            af[mt] = __builtin_bit_cast(bf16x8_, hw); }
#pragma unroll
        for (int nt = 0; nt < 4; ++nt) bfr[nt] = *(const bf16x8_*)(w2t + (16 * nt + l15) * 136 + 32 * ks + 8 * g);
#pragma unroll
        for (int mt = 0; mt < 2; ++mt)
#pragma unroll
            for (int nt = 0; nt < 4; ++nt) acc[mt][nt] = __builtin_amdgcn_mfma_f32_16x16x32_bf16(af[mt], bfr[nt], acc[mt][nt], 0, 0, 0);
    }
#pragma unroll
    for (int mt = 0; mt < 2; ++mt)
#pragma unroll
        for (int r = 0; r < 4; ++r) { const int row = row0 + 16 * mt + 4 * g + r; const bool pad = (row & 127) == 127;
#pragma unroll
            for (int nt = 0; nt < 4; ++nt) dst[(size_t)row * 64 + 16 * nt + l15] = pad ? (bf16_t)0 : f2bf(acc[mt][nt][r]); }
}

namespace att {
typedef short bf16x8 __attribute__((ext_vector_type(8)));
typedef short s16x4 __attribute__((ext_vector_type(4)));
typedef float f32x16 __attribute__((ext_vector_type(16)));
typedef float f32x2_t __attribute__((ext_vector_type(2))); typedef __bf16 bf16x2_t __attribute__((ext_vector_type(2)));
typedef const LAS char* lds_cptr;
constexpr float C2 = 0.125f * 1.4426950408889634f;
__device__ __forceinline__ int crow(int r, int hi) { return (r & 3) + 8 * (r >> 2) + 4 * hi; }
__device__ __forceinline__ unsigned cvtpk(float lo, float hi) { f32x2_t v = {lo, hi}; bf16x2_t b = __builtin_convertvector(v, bf16x2_t); return __builtin_bit_cast(unsigned, b); }
typedef unsigned u32x4v __attribute__((ext_vector_type(4)));
struct TileRegs { u32x4v k, v; };
__device__ __forceinline__ TileRegs tile_fetch(const bf16_t* kb, int kpitch, const bf16_t* vb, int vpitch, int wid, int lane) {
    TileRegs t; t.k = *(const u32x4v*)(kb + (size_t)lane * kpitch + wid * 8);
    t.v = *(const u32x4v*)(vb + (size_t)(16 * (wid & 3) + (lane >> 2)) * vpitch + (wid >> 2) * 32 + (lane & 3) * 8); return t; }
__device__ __forceinline__ void tile_dma(LAS char* kbuf, LAS char* vbuf, const bf16_t* kb, int kpitch, const bf16_t* vb, int vpitch, int wid, int lane) {
    __builtin_amdgcn_global_load_lds((const unsigned*)(kb + (size_t)lane * kpitch + wid * 8), (LAS unsigned*)(kbuf + wid * 1024), 16, 0, 0);
    __builtin_amdgcn_global_load_lds((const unsigned*)(vb + (size_t)(16 * (wid & 3) + (lane >> 2)) * vpitch + (wid >> 2) * 32 + (lane & 3) * 8), (LAS unsigned*)(vbuf + wid * 1024), 16, 0, 0);
}
__device__ __forceinline__ void tile_store(LAS char* kbuf, LAS char* vbuf, const TileRegs& t, int wid, int lane) {
    *(LAS u32x4v*)(kbuf + wid * 1024 + lane * 16) = t.k; *(LAS u32x4v*)(vbuf + wid * 1024 + lane * 16) = t.v; }
__device__ __forceinline__ void qk_tile(f32x16& p0, f32x16& p1, lds_cptr kp, lds_cptr qp) {
    f32x16 z;
#pragma unroll
    for (int r = 0; r < 16; ++r) z[r] = 0.f;
    p0 = z; p1 = z;
#pragma unroll
    for (int d0 = 0; d0 < 4; ++d0) {
        const bf16x8 b0 = *(const LAS bf16x8*)(kp + d0 * 2048), b1 = *(const LAS bf16x8*)(kp + d0 * 2048 + 512), q = *(const LAS bf16x8*)(qp + d0 * 1024);
        p0 = __builtin_amdgcn_mfma_f32_32x32x16_bf16(b0, q, p0, 0, 0, 0); p1 = __builtin_amdgcn_mfma_f32_32x32x16_bf16(b1, q, p1, 0, 0, 0); }
}
__device__ __forceinline__ s16x4 vtr(lds_cptr p) { typedef short v4i16_t __attribute__((ext_vector_type(4))); return __builtin_bit_cast(s16x4, __builtin_amdgcn_ds_read_tr16_b64_v4i16((LAS v4i16_t*)p)); }
__device__ __forceinline__ void pv_tile(f32x16& o0, f32x16& o1, lds_cptr vp, const f32x16& p0, const f32x16& p1) {
    bf16x8 pa[4];
    { typedef unsigned u32x4_t __attribute__((ext_vector_type(4)));
      u32x4_t w0 = {cvtpk(p0[0], p0[1]), cvtpk(p0[2], p0[3]), cvtpk(p0[4], p0[5]), cvtpk(p0[6], p0[7])}; u32x4_t w1 = {cvtpk(p0[8], p0[9]), cvtpk(p0[10], p0[11]), cvtpk(p0[12], p0[13]), cvtpk(p0[14], p0[15])};
      u32x4_t w2 = {cvtpk(p1[0], p1[1]), cvtpk(p1[2], p1[3]), cvtpk(p1[4], p1[5]), cvtpk(p1[6], p1[7])}; u32x4_t w3 = {cvtpk(p1[8], p1[9]), cvtpk(p1[10], p1[11]), cvtpk(p1[12], p1[13]), cvtpk(p1[14], p1[15])};
      pa[0] = __builtin_bit_cast(bf16x8, w0); pa[1] = __builtin_bit_cast(bf16x8, w1); pa[2] = __builtin_bit_cast(bf16x8, w2); pa[3] = __builtin_bit_cast(bf16x8, w3); }
#pragma unroll
    for (int ks = 0; ks < 4; ++ks) {
        const s16x4 l0 = vtr(vp + ks * 1024), h0 = vtr(vp + ks * 1024 + 512), l1 = vtr(vp + 4096 + ks * 1024), h1 = vtr(vp + 4096 + ks * 1024 + 512);
        const bf16x8 v0 = {l0[0], l0[1], l0[2], l0[3], h0[0], h0[1], h0[2], h0[3]}, v1 = {l1[0], l1[1], l1[2], l1[3], h1[0], h1[1], h1[2], h1[3]};
        o0 = __builtin_amdgcn_mfma_f32_32x32x16_bf16(pa[ks], v0, o0, 0, 0, 0); o1 = __builtin_amdgcn_mfma_f32_32x32x16_bf16(pa[ks], v1, o1, 0, 0, 0); }
}
__device__ __forceinline__ float max3f(float a, float b, float c) { return fmaxf(fmaxf(a, b), c); }
__device__ __forceinline__ void softmax_step(f32x16& p0, f32x16& p1, float bias, bool need_mask, int key0, int t, int lo, int hi, int r32, float& mhat, float& lsum, f32x16& o0, f32x16& o1, LAS float* wsf) {
    if (need_mask) {
        asm volatile("" ::: "memory");
#pragma unroll
        for (int r = 0; r < 16; ++r) { const int k = key0 + crow(r, hi); if (!(k <= t && k >= lo)) p0[r] = -INFINITY; if (!(k + 32 <= t && k + 32 >= lo)) p1[r] = -INFINITY; }
    }
    float ra = max3f(p0[0], p0[1], p1[0]), rb = max3f(p0[2], p0[3], p1[1]); ra = max3f(ra, p1[2], p1[3]);
#pragma unroll
    for (int r = 4; r < 16; r += 4) { ra = max3f(ra, p0[r], p0[r + 1]); rb = max3f(rb, p0[r + 2], p0[r + 3]); ra = max3f(ra, p1[r], p1[r + 1]); rb = max3f(rb, p1[r + 2], p1[r + 3]); }
    float rm = half_max(fmaxf(ra, rb));
    rm = fmaf(rm, C2, bias);
    if (__any(rm > mhat + 8.0f)) {
        const float mnew = fmaxf(mhat, rm); const float f = __builtin_amdgcn_exp2f(mhat - mnew); lsum *= f; mhat = mnew;
        if (hi == 0) wsf[r32] = f;
        wave_lds_sync();
#pragma unroll
        for (int r = 0; r < 16; ++r) { const float fr = wsf[crow(r, hi)]; o0[r] *= fr; o1[r] *= fr; }
        wave_lds_sync();
    }
    const float nb = bias - mhat; float sacc = 0.f;
#pragma unroll
    for (int r = 0; r < 16; ++r) { p0[r] = __builtin_amdgcn_exp2f(fmaf(p0[r], C2, nb)); p1[r] = __builtin_amdgcn_exp2f(fmaf(p1[r], C2, nb)); sacc += p0[r] + p1[r]; }
    lsum += sacc;
}
template <bool ADD> __device__ __forceinline__ void add_scaled(LAS float* OT, const f32x16& o0, const f32x16& o1, float fac, int hi, int r32, LAS float* wsf) {
    wave_lds_sync();
    if (hi == 0) wsf[32 + r32] = fac;
    wave_lds_sync();
#pragma unroll
    for (int r = 0; r < 16; ++r) { const float fr = wsf[32 + crow(r, hi)]; LAS float* q = OT + crow(r, hi) * 64 + r32;
        if (ADD) { q[0] += o0[r] * fr; q[32] += o1[r] * fr; } else { q[0] = o0[r] * fr; q[32] = o1[r] * fr; } }
    wave_lds_sync();
}
__device__ __forceinline__ float imp_sum(const LAS float* IMP, const LAS float* INV, int tk, int i) {
    return ((IMP[(0 * 64 + tk) * 33 + i] * INV[tk] + IMP[(1 * 64 + tk) * 33 + i] * INV[64 + tk]) + IMP[(2 * 64 + tk) * 33 + i] * INV[128 + tk]) + IMP[(3 * 64 + tk) * 33 + i] * INV[192 + tk]; }

__device__ __forceinline__ void glds16(const void* sbase, unsigned voff, unsigned lds_dst) { unsigned keep;
    asm volatile("s_mov_b32 %0, m0\n\ts_mov_b32 m0, %3\n\ts_nop 0\n\tglobal_load_lds_dwordx4 %1, %2\n\ts_mov_b32 m0, %0" : "=&s"(keep) : "v"(voff), "s"(sbase), "s"(lds_dst) : "memory"); }
__device__ __forceinline__ void kload8(bf16x8* kf, lds_cptr kp) {
    kf[0] = *(const LAS bf16x8*)(kp);        kf[1] = *(const LAS bf16x8*)(kp + 512);  kf[2] = *(const LAS bf16x8*)(kp + 2048); kf[3] = *(const LAS bf16x8*)(kp + 2560);
    kf[4] = *(const LAS bf16x8*)(kp + 4096); kf[5] = *(const LAS bf16x8*)(kp + 4608); kf[6] = *(const LAS bf16x8*)(kp + 6144); kf[7] = *(const LAS bf16x8*)(kp + 6656); }
__device__ __forceinline__ void kload2(bf16x8* kf, lds_cptr kp, int j) { kf[2 * j] = *(const LAS bf16x8*)(kp + j * 2048); kf[2 * j + 1] = *(const LAS bf16x8*)(kp + j * 2048 + 512); }
__device__ __forceinline__ float swapmax(float m) { auto rr = __builtin_amdgcn_permlane32_swap(__float_as_uint(m), __float_as_uint(m), false, false); return fmaxf(__uint_as_float(rr[0]), __uint_as_float(rr[1])); }
}

__device__ __forceinline__ void ph_attn(const Params& p, unsigned char* smem, unsigned* qctr) {
    using namespace att;
    const int tidx = fresh_tid();
    const bf16_t* PA = (const bf16_t*)(p.ws + WS_PA); const bf16_t* PG = (const bf16_t*)(p.ws + WS_PG);
    const bf16_t* KCB = (const bf16_t*)(p.ws + WS_KCMP); const bf16_t* VCB = (const bf16_t*)(p.ws + WS_VCMP);
    bf16_t* onsa = (bf16_t*)(p.ws + WS_HBF);
    LAS char* lds = (LAS char*)smem;
    LAS float* IMP = (LAS float*)(lds + 67584);
    LAS unsigned* SEL = (LAS unsigned*)(lds + 133120); LAS float* INV = (LAS float*)(lds + 133120 + 256);
    volatile LAS int* qslot = (volatile LAS int*)(lds + (144 * 1024 - 32));
    unsigned nxt = 0;
    if (tidx == 0) nxt = __hip_atomic_fetch_add(qctr, 1u, __ATOMIC_RELAXED, __HIP_MEMORY_SCOPE_AGENT);
    for (;;) {
      __syncthreads();
      if (tidx == 0) *qslot = (int)nxt;
      __syncthreads();
      const int qi = __builtin_amdgcn_readfirstlane(*qslot);
      if (qi >= 1024) break;
      if (tidx == 0) nxt = __hip_atomic_fetch_add(qctr, 1u, __ATOMIC_RELAXED, __HIP_MEMORY_SCOPE_AGENT);
      const int qt = 31 - (qi >> 5), bg = qi & 31, b = bg >> 1, g = bg & 1;
      const bf16_t* PAb = PA + (size_t)b * 2048 * 1280;
      const int tid = fresh_tid(); const int lane = tid & 63, r32 = lane & 31, hi = lane >> 5, wid = __builtin_amdgcn_readfirstlane(tid >> 6);
      LAS char* KB[2] = {lds, lds + 8192}; LAS char* VB[2] = {lds + 16384, lds + 24576};
      LAS float* wsf = (LAS float*)(lds + 32768) + wid * 64;
      LAS char* QL = lds + 34816 + wid * 4096;
      LAS float* OT = (LAS float*)(lds + 67584) + wid * 2048;
      const int kfo = hi * 1024 + r32 * 16;
      const int vfo = ((lane >> 4) & 1) * 32 + (lane & 3) * 8 + (4 * hi + ((lane & 15) >> 2)) * 64;
      lds_cptr qp = QL + hi * 512 + r32 * 16;
      {
        const int th = wid >> 2, rh = wid & 3, h = 4 * g + rh, tloc = 32 * th + r32, t = 64 * qt + tloc; const size_t tok = (size_t)b * 2048 + t;
#pragma unroll
        for (int d0 = 0; d0 < 4; ++d0) *(LAS u32x4v*)(QL + hi * 512 + r32 * 16 + d0 * 1024) = *(const u32x4v*)(PA + tok * 1280 + h * 64 + 16 * d0 + 8 * hi);
        const bf16_t gl0 = PG[tok * 256 + h * 3], gl1 = PG[tok * 256 + h * 3 + 1], gl2 = PG[tok * 256 + h * 3 + 2];
        LAS float* GATE = (LAS float*)(lds + 142848);
        f32x16 o0, o1, pA0, pA1;
        float cinv;
        {
            const bf16_t* kc = KCB + (size_t)(b * 2 + g) * 128 * 64; const bf16_t* vc = VCB + (size_t)(b * 2 + g) * 128 * 64;
            const int nct = (qt >= 16) ? 2 : 1;
            tile_dma(KB[0], VB[0], kc, 64, vc, 64, wid, lane); if (nct == 2) tile_dma(KB[1], VB[1], kc + 64 * 64, 64, vc + 64 * 64, 64, wid, lane);
            if (hi == 0) { GATE[(wid * 3 + 0) * 32 + r32] = sigmoidf_(bf2f(gl0)); GATE[(wid * 3 + 1) * 32 + r32] = sigmoidf_(bf2f(gl1)); GATE[(wid * 3 + 2) * 32 + r32] = sigmoidf_(bf2f(gl2)); }
            __syncthreads();
            const int nv = (t >= 31) ? ((t - 31) >> 4) + 1 : 0;
            float rm = -INFINITY;
#pragma unroll
            for (int ct = 0; ct < 2; ++ct) { if (ct < nct) {
                qk_tile(pA0, pA1, KB[ct] + kfo, qp);
#pragma unroll
                for (int r = 0; r < 16; ++r) { const int n = 64 * ct + crow(r, hi); rm = fmaxf(rm, fmaxf((n < nv) ? pA0[r] : -INFINITY, (n + 32 < nv) ? pA1[r] : -INFINITY)); }
            } }
            rm = half_max(rm); const float mref = (rm > -INFINITY) ? rm * C2 : 0.f;
            float ls = 0.f, a7 = 0.f;
#pragma unroll
            for (int r = 0; r < 16; ++r) { o0[r] = 0.f; o1[r] = 0.f; }
#pragma unroll
            for (int ct = 0; ct < 2; ++ct) { if (ct < nct) {
                qk_tile(pA0, pA1, KB[ct] + kfo, qp);
#pragma unroll
                for (int r = 0; r < 16; ++r) { const int n = 64 * ct + crow(r, hi);
                    pA0[r] = (n < nv) ? __builtin_amdgcn_exp2f(fmaf(pA0[r], C2, -mref)) : 0.f; pA1[r] = (n + 32 < nv) ? __builtin_amdgcn_exp2f(fmaf(pA1[r], C2, -mref)) : 0.f; ls += pA0[r] + pA1[r]; }
                if (qt >= 16) {
                    float F[8], A[8], PF[8];
#pragma unroll
                    for (int gq = 0; gq < 4; ++gq) {
                        F[gq] = pA0[4 * gq]; A[gq] = pA0[4 * gq] + 2.0f * ((pA0[4 * gq + 1] + pA0[4 * gq + 2]) + pA0[4 * gq + 3]);
                        F[4 + gq] = pA1[4 * gq]; A[4 + gq] = pA1[4 * gq] + 2.0f * ((pA1[4 * gq + 1] + pA1[4 * gq + 2]) + pA1[4 * gq + 3]); }
#pragma unroll
                    for (int q = 0; q < 8; ++q) PF[q] = half_other(F[q]);
                    LAS float* dst = IMP + (rh * 64 + tloc) * 33 + 16 * ct + hi;
                    const unsigned himask = 0u - (unsigned)hi;
#pragma unroll
                    for (int q = 0; q < 7; ++q) dst[2 * q] = A[q] + __uint_as_float((__float_as_uint(PF[q]) & ~himask) | (__float_as_uint(PF[q + 1]) & himask));
                    if (ct == 0) { if (hi == 0) dst[14] = A[7] + PF[7]; else { a7 = A[7]; } }
                    else { if (hi) { dst[14 - 16] = a7 + PF[0]; dst[14] = A[7]; } else dst[14] = A[7] + PF[7]; }
                }
                pv_tile(o0, o1, VB[ct] + vfo, pA0, pA1);
            } }
            ls = half_sum(ls); cinv = ls > 0.f ? 1.0f / ls : 0.f;
        }
        unsigned selmask;
        if (qt >= 16) {
            const int tid2 = fresh_tid(); const int lane2 = tid2 & 63, wid2 = tid2 >> 6, tloc2 = 32 * (wid2 >> 2) + (lane2 & 31);
            if (lane2 < 32) INV[(wid2 & 3) * 64 + tloc2] = cinv;
            __syncthreads();
            { const int tk = tid2 >> 3, jg = tid2 & 7;
              LAS float* VAL = (LAS float*)(lds + 134400);
#pragma unroll
              for (int jj = 0; jj < 4; ++jj) { const int j = 4 * jg + jj; const float v = imp_sum(IMP, INV, tk, j); const bool forced = (j == 0) || (j == qt) || (j == qt - 1);
                  VAL[tk * 33 + j] = (j <= qt) ? v + (forced ? 1000.f : 0.f) : -1.0f; }
              __syncthreads();
              float vj[4]; int rank[4] = {0, 0, 0, 0};
#pragma unroll
              for (int jj = 0; jj < 4; ++jj) vj[jj] = VAL[tk * 33 + 4 * jg + jj];
#pragma unroll 4
              for (int i = 0; i < 32; ++i) { const float vi = VAL[tk * 33 + i];
#pragma unroll
                  for (int jj = 0; jj < 4; ++jj) rank[jj] += ((vi > vj[jj]) || (vi == vj[jj] && i < 4 * jg + jj)) ? 1 : 0; }
              unsigned bits = 0;
#pragma unroll
              for (int jj = 0; jj < 4; ++jj) if (rank[jj] < 16 && 4 * jg + jj <= qt) bits |= 1u << (4 * jg + jj);
              bits |= xor_getu<1>(bits); bits |= xor_getu<2>(bits); bits |= xor_getu<4>(bits);
              if (jg == 0) SEL[tk] = bits; }
            __syncthreads();
            selmask = SEL[tloc2];
        } else selmask = (2u << qt) - 1u;
        add_scaled<false>(OT, o0, o1, GATE[(wid * 3) * 32 + r32] * cinv, hi, r32, wsf);
#pragma unroll 1
        for (int br = 1; br < 3; ++br) {
            const int j0 = (br == 1) ? 0 : (qt > 8 ? qt - 8 : 0);
            const int koff = (br == 1 ? 768 : 1024) + g * 64, voff = (br == 1 ? 896 : 1152) + g * 64;
            const int lo = (br == 1) ? -(1 << 30) : t - 511;
            float mhat = -1e30f, lsum = 0.f;
#pragma unroll
            for (int r = 0; r < 16; ++r) { o0[r] = 0.f; o1[r] = 0.f; }
            const unsigned kvo = (unsigned)(lane * 2560 + wid * 16), vvo = (unsigned)((16 * (wid & 3) + (lane >> 2)) * 2560 + (wid >> 2) * 64 + (lane & 3) * 16);
            const unsigned lds0 = (unsigned)(uintptr_t)lds;
#define DMA_K(tt) glds16(PAb + koff + (size_t)(tt) * (64 * 1280), kvo, (unsigned)__builtin_amdgcn_readfirstlane(lds0 + wid * 1024 + (((tt) & 1) << 13)))
#define DMA_V(tt) glds16(PAb + voff + (size_t)(tt) * (64 * 1280), vvo, (unsigned)__builtin_amdgcn_readfirstlane(lds0 + 16384 + wid * 1024 + (((tt) & 1) << 13)))
#define WAIT_BAR() asm volatile("s_waitcnt vmcnt(0) lgkmcnt(0)\n\ts_barrier" ::: "memory")
#define SBAR() __builtin_amdgcn_sched_barrier(0)
#define MFMA32(a, b, c) __builtin_amdgcn_mfma_f32_32x32x16_bf16(a, b, c, 0, 0, 0)
            __syncthreads();
            DMA_K(j0); DMA_V(j0);
            WAIT_BAR();
            f32x16 pB0, pB1; bool resc = false;
            if (j0 < qt) DMA_K(j0 + 1);
            qk_tile(pA0, pA1, lds + ((j0 & 1) << 13) + kfo, qp);
#define MASKT(C0, C1, tt) do { if (((tt) == qt) || (br == 2 && (tt) == qt - 8)) { asm volatile("" ::: "memory"); \
                _Pragma("unroll") for (int r = 0; r < 16; ++r) { const int k_ = 64 * (tt) + crow(r, hi); if (!(k_ <= t && k_ >= lo)) C0[r] = -INFINITY; if (!(k_ + 32 <= t && k_ + 32 >= lo)) C1[r] = -INFINITY; } } } while (0)
#define DECIDE(C0, C1, tt) \
                const float bias_ = (br == 1 && !((selmask >> (tt)) & 1u)) ? -INFINITY : 0.f; \
                { float a_ = max3f(C0[0], C0[1], C1[0]), b_ = max3f(C0[2], C0[3], C1[1]); a_ = max3f(a_, C1[2], C1[3]); \
                  _Pragma("unroll") for (int r = 4; r < 16; r += 4) { a_ = max3f(a_, C0[r], C0[r + 1]); b_ = max3f(b_, C0[r + 2], C0[r + 3]); a_ = max3f(a_, C1[r], C1[r + 1]); b_ = max3f(b_, C1[r + 2], C1[r + 3]); } \
                  float rm_ = swapmax(fmaxf(a_, b_)); rm_ = fmaf(rm_, C2, bias_); resc = false; \
                  if (__any(rm_ > mhat + 8.0f)) { const float mnew_ = fmaxf(mhat, rm_); const float f_ = __builtin_amdgcn_exp2f(mhat - mnew_); lsum *= f_; mhat = mnew_; if (hi == 0) wsf[r32] = f_; resc = true; } } \
                const float nb_ = bias_ - mhat;
            { MASKT(pA0, pA1, j0); DECIDE(pA0, pA1, j0)
#pragma unroll
              for (int r = 0; r < 16; ++r) { pA0[r] = __builtin_amdgcn_exp2f(fmaf(pA0[r], C2, nb_)); pA1[r] = __builtin_amdgcn_exp2f(fmaf(pA1[r], C2, nb_)); } }
            WAIT_BAR();
            s16x4 vlo[8], vhi[8]; u32x4v pw0, pw1, pw2, pw3;
#define PKW(P, B) cvtpk(P[B], P[(B) + 1])
#define PAF(k) __builtin_bit_cast(bf16x8, pw##k)
#define VFR(i) (bf16x8){vlo[i][0], vlo[i][1], vlo[i][2], vlo[i][3], vhi[i][0], vhi[i][1], vhi[i][2], vhi[i][3]}
#define PIN(x) asm volatile("" : "+v"(x))
#define GAPA(MF, A0, A1, A2, A3, W0, W1, PW) do { MF; sacc += A0; sacc += A1; sacc += A2; sacc += A3; PIN(sacc); W0; W1; PIN(PW); SBAR(); } while (0)
#define EXF(v) __builtin_amdgcn_exp2f(fmaf(v, C2, nb_))
#define GAPB(MF, X, B) do { MF; X[B] = EXF(X[B]); X[(B) + 1] = EXF(X[(B) + 1]); X[(B) + 2] = EXF(X[(B) + 2]); X[(B) + 3] = EXF(X[(B) + 3]); PIN(X); SBAR(); } while (0)
#define VRD(i) do { vlo[i] = vtr(vp_ + (((i) >> 2) * 4096 + ((i) & 3) * 1024)); vhi[i] = vtr(vp_ + (((i) >> 2) * 4096 + ((i) & 3) * 1024 + 512)); } while (0)
#define KFR(i) (*(const LAS bf16x8*)(kp_ + ((i) >> 1) * 2048 + ((i) & 1) * 512))
#define STEP(C0, C1, P0, P1, tt) do { SBAR(); \
                const lds_cptr vp_ = lds + 16384 + ((((tt) - 1) & 1) << 13) + vfo; const lds_cptr kp_ = lds + (((tt) & 1) << 13) + kfo; \
                const f32x16 z16 = {0.f, 0.f, 0.f, 0.f, 0.f, 0.f, 0.f, 0.f, 0.f, 0.f, 0.f, 0.f, 0.f, 0.f, 0.f, 0.f}; \
                bf16x8 q_ = *(const LAS bf16x8*)(qp), ka_ = KFR(0), kb_; \
                VRD(0); kb_ = KFR(1); SBAR(); float sacc = (P0[0] + P0[1]); \
                GAPA(C0 = MFMA32(ka_, q_, z16), P0[2], P0[3], P0[4], P0[5],     pw0[0] = PKW(P0, 0),  pw0[1] = PKW(P0, 2),  pw0); \
                VRD(4); ka_ = KFR(2); SBAR(); GAPA(C1 = MFMA32(kb_, q_, z16), P0[6], P0[7], P0[8], P0[9],     pw0[2] = PKW(P0, 4),  pw0[3] = PKW(P0, 6),  pw0); \
                q_ = *(const LAS bf16x8*)(qp + 1024); \
                kb_ = KFR(3); SBAR(); GAPA(C0 = MFMA32(ka_, q_, C0),  P0[10], P0[11], P0[12], P0[13], pw1[0] = PKW(P0, 8),  pw1[1] = PKW(P0, 10), pw1); \
                ka_ = KFR(4); SBAR(); GAPA(C1 = MFMA32(kb_, q_, C1),  P0[14], P0[15], P1[0], P1[1],   pw1[2] = PKW(P0, 12), pw1[3] = PKW(P0, 14), pw1); \
                q_ = *(const LAS bf16x8*)(qp + 2048); \
                kb_ = KFR(5); SBAR(); GAPA(C0 = MFMA32(ka_, q_, C0),  P1[2], P1[3], P1[4], P1[5],     pw2[0] = PKW(P1, 0),  pw2[1] = PKW(P1, 2),  pw2); \
                ka_ = KFR(6); SBAR(); GAPA(C1 = MFMA32(kb_, q_, C1),  P1[6], P1[7], P1[8], P1[9],     pw2[2] = PKW(P1, 4),  pw2[3] = PKW(P1, 6),  pw2); \
                q_ = *(const LAS bf16x8*)(qp + 3072); \
                kb_ = KFR(7); SBAR(); GAPA(C0 = MFMA32(ka_, q_, C0),  P1[10], P1[11], P1[12], P1[13], pw3[0] = PKW(P1, 8),  pw3[1] = PKW(P1, 10), pw3); \
                SBAR(); GAPA(C1 = MFMA32(kb_, q_, C1),  P1[14], P1[15], 0.f, 0.f,       pw3[2] = PKW(P1, 12), pw3[3] = PKW(P1, 14), pw3); \
                lsum += sacc; \
                if ((tt) + 1 <= qt) DMA_K((tt) + 1); DMA_V(tt); \
                MASKT(C0, C1, tt); DECIDE(C0, C1, tt) \
                SBAR(); \
                VRD(1); SBAR(); GAPB(o0 = MFMA32(PAF(0), VFR(0), o0), C0, 0); \
                VRD(5); SBAR(); GAPB(o1 = MFMA32(PAF(0), VFR(4), o1), C0, 4); \
                VRD(2); SBAR(); GAPB(o0 = MFMA32(PAF(1), VFR(1), o0), C0, 8); \
                VRD(6); SBAR(); GAPB(o1 = MFMA32(PAF(1), VFR(5), o1), C0, 12); \
                VRD(3); SBAR(); GAPB(o0 = MFMA32(PAF(2), VFR(2), o0), C1, 0); \
                VRD(7); SBAR(); GAPB(o1 = MFMA32(PAF(2), VFR(6), o1), C1, 4); \
                GAPB(o0 = MFMA32(PAF(3), VFR(3), o0), C1, 8); \
                GAPB(o1 = MFMA32(PAF(3), VFR(7), o1), C1, 12); \
                WAIT_BAR(); \
                if (resc) { _Pragma("unroll") for (int r = 0; r < 16; ++r) { const float fr_ = wsf[crow(r, hi)]; o0[r] *= fr_; o1[r] *= fr_; } wave_lds_sync(); } \
            } while (0)
#define DRAIN(P0, P1) do { float sacc = 0.f; _Pragma("unroll") for (int r = 0; r < 16; ++r) sacc += P0[r] + P1[r]; lsum += sacc; pv_tile(o0, o1, lds + 16384 + ((qt & 1) << 13) + vfo, P0, P1); } while (0)
            { int tt = j0 + 1;
              for (; tt + 1 <= qt; tt += 2) { STEP(pB0, pB1, pA0, pA1, tt); STEP(pA0, pA1, pB0, pB1, tt + 1); }
              if (tt <= qt) { STEP(pB0, pB1, pA0, pA1, tt); DRAIN(pB0, pB1); } else { DRAIN(pA0, pA1); } }
#undef DMA_K
#undef DMA_V
#undef WAIT_BAR
#undef MASKT
#undef DECIDE
#undef PKW
#undef PAF
#undef VFR
#undef PIN
#undef GAPA
#undef EXF
#undef GAPB
#undef VRD
#undef KFR
#undef STEP
#undef DRAIN
#undef MFMA32
#undef SBAR
            lsum = half_sum(lsum);
            { const int tid3 = fresh_tid(); const int lane3 = tid3 & 63, r323 = lane3 & 31, hi3 = lane3 >> 5, wid3 = __builtin_amdgcn_readfirstlane(tid3 >> 6);
              add_scaled<true>((LAS float*)(lds + 67584) + wid3 * 2048, o0, o1, lsum > 0.f ? ((const LAS float*)(lds + 142848))[(wid3 * 3 + br) * 32 + r323] / lsum : 0.f, hi3, r323, (LAS float*)(lds + 32768) + wid3 * 64); }
        }
        { const int tid4 = fresh_tid(); const int lane4 = tid4 & 63, wid4 = __builtin_amdgcn_readfirstlane(tid4 >> 6);
          const int row = lane4 >> 1, c0 = (lane4 & 1) * 32; const LAS float* src = (LAS float*)(lds + 67584) + wid4 * 2048 + row * 64 + c0;
          bf16_t* dst = onsa + ((size_t)b * 2048 + 64 * qt + 32 * (wid4 >> 2) + row) * 1024 + (4 * g + (wid4 & 3)) * 64 + c0;
#pragma unroll
          for (int q = 0; q < 4; ++q) { u32x4v w;
              w.x = cvtpk(src[8 * q], src[8 * q + 1]); w.y = cvtpk(src[8 * q + 2], src[8 * q + 3]); w.z = cvtpk(src[8 * q + 4], src[8 * q + 5]); w.w = cvtpk(src[8 * q + 6], src[8 * q + 7]);
              *(u32x4v*)(dst + 8 * q) = w; } }
        __syncthreads();
      }
    }
}

__device__ __forceinline__ size_t ph_off(int row, int col) {
    const int r = row & 255, c = col & 255;
    return (size_t)((row >> 8) * 8 + (col >> 8)) * 65536 + (((r >> 6) & 1) * 4 + ((c >> 5) & 3)) * 8192 + ((((r >> 7) * 4 + ((r >> 4) & 3)) * 2 + (c >> 7)) * 64 + ((c >> 3) & 3) * 16 + (r & 15)) * 8 + (c & 7);
}
namespace hg {
typedef short bf16x8 __attribute__((ext_vector_type(8)));
typedef short s16x4 __attribute__((ext_vector_type(4)));
typedef float f32x4 __attribute__((ext_vector_type(4)));
typedef unsigned u32x4 __attribute__((ext_vector_type(4)));
constexpr int QS = 136, TS = 40, OS = 132;
constexpr int QD_OFF = 0, KI_OFF = 8704, KET_OFF = 17408, VT_OFF = 27648, DEC_OFF = 37888, PART_OFF = 38400, OB_OFF = 40448;
__device__ __forceinline__ unsigned cvtpk(float lo, float hi) { typedef float f32x2_t __attribute__((ext_vector_type(2))); typedef __bf16 bf16x2_t __attribute__((ext_vector_type(2))); f32x2_t v = {lo, hi}; bf16x2_t b = __builtin_convertvector(v, bf16x2_t); return __builtin_bit_cast(unsigned, b); }
__device__ __forceinline__ bf16x8 pack8(const f32x4& a, const f32x4& b) { u32x4 w = {cvtpk(a[0], a[1]), cvtpk(a[2], a[3]), cvtpk(b[0], b[1]), cvtpk(b[2], b[3])}; return __builtin_bit_cast(bf16x8, w); }
__device__ __forceinline__ bf16x8 cat8(s16x4 a, s16x4 b) { bf16x8 r = {a[0], a[1], a[2], a[3], b[0], b[1], b[2], b[3]}; return r; }
}
constexpr int HP_PITCH = 25088;
__device__ __forceinline__ void ph_hgrn_pre(const Params& p, unsigned char* smem, int first, int stride) {
    using namespace hg;
    const int tidx = fresh_tid();
    const int d = tidx & 127, tq = tidx >> 7;
    float* PART = (float*)smem;
    for (int item = first; item < 4096; item += stride) {
        const int bh = item >> 6, c = item & 63, b = bh >> 2, h = bh & 3;
        const bf16_t* ph = (const bf16_t*)(p.ws + WS_PH); const int prow = b * 2048 + c * 32 + 8 * tq;
        unsigned char* blk = (unsigned char*)p.out + DO_HP + (size_t)item * HP_PITCH;
        const float lbv = ((const float*)(p.ws + WS_LB))[h * 128 + d];
        float lf[8], kk[8], qs[8];
#pragma unroll
        for (int i = 0; i < 8; ++i) { const float hq = bf2f(ph[ph_off(prow + i, h * 128 + d)]);
            const float f = lbv + (1.0f - lbv) * sigmoidf_(bf2f(ph[ph_off(prow + i, 512 + h * 128 + d)])); lf[i] = f; kk[i] = 1.0f - f; qs[i] = hq * sigmoidf_(hq); }
#pragma unroll
        for (int i = 1; i < 8; ++i) lf[i] *= lf[i - 1];
        __syncthreads();
        PART[tq * 128 + d] = lf[7];
        __syncthreads();
        float prefix = 1.f, ebend = 1.f;
#pragma unroll
        for (int q = 0; q < 4; ++q) { const float pv = PART[q * 128 + d]; ebend *= pv; if (q < tq) prefix *= pv; }
        float ke[8];
        bf16_t* qd = (bf16_t*)blk; bf16_t* ki_ = (bf16_t*)(blk + 8192);
#pragma unroll
        for (int i = 0; i < 8; ++i) { const float eb = prefix * lf[i], einv = __builtin_amdgcn_rcpf(eb), ki = kk[i] * einv;
            qd[(8 * tq + i) * 128 + d] = f2bf(qs[i] * eb); ki_[(8 * tq + i) * 128 + d] = f2bf(ki); ke[i] = ki * ebend; }
        const u32x4 w = {cvtpk(ke[0], ke[1]), cvtpk(ke[2], ke[3]), cvtpk(ke[4], ke[5]), cvtpk(ke[6], ke[7])};
        *(u32x4*)(blk + 16384 + (d * 32 + 8 * tq) * 2) = w;
        if (tq == 0) ((float*)(blk + 24576))[d] = ebend;
    }
}
__device__ __forceinline__ void ph_hgrn(const Params& p, unsigned char* smem, int item) {
    using namespace hg;
    const int tidx = fresh_tid();
    const int lane = tidx & 63, l15 = lane & 15, g = lane >> 4, wid = __builtin_amdgcn_readfirstlane(tidx >> 6), e0 = 16 * wid;
    const int b = item >> 2, h = item & 3, d = tidx & 127, tq = tidx >> 7;
    const bf16_t* ph = (const bf16_t*)(p.ws + WS_PH); bf16_t* oh = (bf16_t*)(p.ws + WS_HBF) + (size_t)b * 2048 * 1024 + 512;
    const unsigned char* hp = (const unsigned char*)p.out + DO_HP + (size_t)item * 64 * HP_PITCH;
    LAS char* lds = (LAS char*)smem;
    LAS float* OB = (LAS float*)(lds + OB_OFF);
    const int qoff = (tidx >> 4) * (QS * 2) + (tidx & 15) * 16, koff_ = (tidx >> 2) * (TS * 2) + (tidx & 3) * 16;
    u32x4 sqA, skA, seA, sdA, gwA, sqB, skB, seB, sdB, gwB; unsigned rvA[8], rvB[8];
    const int t_o = tidx >> 4, eg = tidx & 15;
    const float4 n0 = *(const float4*)(p.out_norm + 8 * eg), n1 = *(const float4*)(p.out_norm + 8 * eg + 4);
    auto ldset = [&](int c, u32x4& sq, u32x4& sk, u32x4& se, u32x4& sd, unsigned (&rv)[8]) __attribute__((always_inline)) {
        const unsigned char* blk = hp + (size_t)c * HP_PITCH; sq = *(const u32x4*)(blk + tidx * 16); sk = *(const u32x4*)(blk + 8192 + tidx * 16); se = *(const u32x4*)(blk + 16384 + tidx * 16);
        sd = *(const u32x4*)(blk + 24576 + (tidx & 31) * 16);
#pragma unroll
        for (int i = 0; i < 8; ++i) rv[i] = ph[ph_off(b * 2048 + c * 32 + 8 * tq + i, 1024 + h * 128 + d)];
    };
    auto ldgate = [&](int c, u32x4& gw) __attribute__((always_inline)) { gw = *(const u32x4*)(ph + ph_off(b * 2048 + c * 32 + t_o, 1536 + h * 128 + 8 * eg)); };
    f32x4 S[8];
#pragma unroll
    for (int dt = 0; dt < 8; ++dt) S[dt] = (f32x4){0.f, 0.f, 0.f, 0.f};
    auto chunk = [&](int c, u32x4& sq, u32x4& sk, u32x4& se, u32x4& sd, u32x4& gw, unsigned (&rv)[8]) __attribute__((always_inline)) {
        *(LAS u32x4*)(lds + QD_OFF + qoff) = sq; *(LAS u32x4*)(lds + KI_OFF + qoff) = sk; *(LAS u32x4*)(lds + KET_OFF + koff_) = se;
        if (tidx < 32) *(LAS u32x4*)(lds + DEC_OFF + tidx * 16) = sd;
#pragma unroll
        for (int i = 0; i < 8; ++i) asm volatile("" : "+v"(rv[i]));
        { u32x4 w = {rv[0] | (rv[1] << 16), rv[2] | (rv[3] << 16), rv[4] | (rv[5] << 16), rv[6] | (rv[7] << 16)};
          *(LAS u32x4*)(lds + VT_OFF + (d * TS + 8 * tq) * 2) = w; }
        ldset(min(c + 2, 63), sq, sk, se, sd, rv);
        __syncthreads();
        {
            bf16x8 qf[2][4], kf[2][4];
#pragma unroll
            for (int tt = 0; tt < 2; ++tt)
#pragma unroll
                for (int ks = 0; ks < 4; ++ks) { const int off = ((16 * tt + l15) * QS + 32 * ks + 4 * g) * 2;
                    qf[tt][ks] = cat8(*(const LAS s16x4*)(lds + QD_OFF + off), *(const LAS s16x4*)(lds + QD_OFF + off + 32));
                    kf[tt][ks] = cat8(*(const LAS s16x4*)(lds + KI_OFF + off), *(const LAS s16x4*)(lds + KI_OFF + off + 32)); }
            f32x4 at00 = {0.f, 0.f, 0.f, 0.f}, at01 = at00, at11 = at00;
#pragma unroll
            for (int ks = 0; ks < 4; ++ks) {
                at00 = __builtin_amdgcn_mfma_f32_16x16x32_bf16(kf[0][ks], qf[0][ks], at00, 0, 0, 0);
                at01 = __builtin_amdgcn_mfma_f32_16x16x32_bf16(kf[0][ks], qf[1][ks], at01, 0, 0, 0);
                at11 = __builtin_amdgcn_mfma_f32_16x16x32_bf16(kf[1][ks], qf[1][ks], at11, 0, 0, 0); }
#pragma unroll
            for (int r = 0; r < 4; ++r) if (4 * g + r > l15) { at00[r] = 0.f; at11[r] = 0.f; }
            const f32x4 zero4 = {0.f, 0.f, 0.f, 0.f};
            const bf16x8 a0 = pack8(at00, zero4), a1 = pack8(at01, at11);
            const int voff = VT_OFF + ((e0 + l15) * TS) * 2;
            const bf16x8 vp = cat8(*(const LAS s16x4*)(lds + voff + 8 * g), *(const LAS s16x4*)(lds + voff + 8 * g + 32));
            f32x4 o0 = __builtin_amdgcn_mfma_f32_16x16x32_bf16(a0, vp, zero4, 0, 0, 0), o1 = __builtin_amdgcn_mfma_f32_16x16x32_bf16(a1, vp, zero4, 0, 0, 0);
#pragma unroll
            for (int ks = 0; ks < 4; ++ks) { const bf16x8 sf = pack8(S[2 * ks], S[2 * ks + 1]);
                o0 = __builtin_amdgcn_mfma_f32_16x16x32_bf16(qf[0][ks], sf, o0, 0, 0, 0); o1 = __builtin_amdgcn_mfma_f32_16x16x32_bf16(qf[1][ks], sf, o1, 0, 0, 0); }
            const bf16x8 vn = *(const LAS bf16x8*)(lds + voff + 16 * g);
#pragma unroll
            for (int dt = 0; dt < 8; ++dt) { const f32x4 dc = *(const LAS f32x4*)(lds + DEC_OFF + (16 * dt + 4 * g) * 4);
                const bf16x8 kef = *(const LAS bf16x8*)(lds + KET_OFF + ((16 * dt + l15) * TS + 8 * g) * 2);
                S[dt] = __builtin_amdgcn_mfma_f32_16x16x32_bf16(kef, vn, S[dt] * dc, 0, 0, 0); }
#pragma unroll
            for (int r = 0; r < 4; ++r) { OB[(4 * g + r) * OS + e0 + l15] = o0[r]; OB[(16 + 4 * g + r) * OS + e0 + l15] = o1[r]; }
        }
        __syncthreads();
        { const int t = t_o; const size_t row = (size_t)c * 32 + t;
          const f32x4 x0 = *(const LAS f32x4*)(lds + OB_OFF + (t * OS + 8 * eg) * 4), x1 = *(const LAS f32x4*)(lds + OB_OFF + (t * OS + 8 * eg + 4) * 4);
          float ss = (x0[0] * x0[0] + x0[1] * x0[1]) + (x0[2] * x0[2] + x0[3] * x0[3]) + (x1[0] * x1[0] + x1[1] * x1[1]) + (x1[2] * x1[2] + x1[3] * x1[3]);
          ss += xor_get<1>(ss); ss += xor_get<2>(ss); ss += xor_get<4>(ss); ss += xor_get<8>(ss);
          const float rstd = rsqrtf(ss * (1.0f / 128.0f) + 1e-6f);
          const float gv[8] = {__uint_as_float(gw[0] << 16), __uint_as_float(gw[0] & 0xffff0000u), __uint_as_float(gw[1] << 16), __uint_as_float(gw[1] & 0xffff0000u),
                               __uint_as_float(gw[2] << 16), __uint_as_float(gw[2] & 0xffff0000u), __uint_as_float(gw[3] << 16), __uint_as_float(gw[3] & 0xffff0000u)};
          const float xv[8] = {x0[0], x0[1], x0[2], x0[3], x1[0], x1[1], x1[2], x1[3]}; const float nv[8] = {n0.x, n0.y, n0.z, n0.w, n1.x, n1.y, n1.z, n1.w};
          float r[8];
#pragma unroll
          for (int i = 0; i < 8; ++i) r[i] = xv[i] * rstd * nv[i] * (gv[i] * sigmoidf_(gv[i]));
          const u32x4 w = {cvtpk(r[0], r[1]), cvtpk(r[2], r[3]), cvtpk(r[4], r[5]), cvtpk(r[6], r[7])};
          *(u32x4*)(oh + row * 1024 + h * 128 + 8 * eg) = w; }
        ldgate(min(c + 2, 63), gw);
    };
    ldset(0, sqA, skA, seA, sdA, rvA); ldgate(0, gwA); ldset(1, sqB, skB, seB, sdB, rvB); ldgate(1, gwB);
    for (int c = 0; c < 64; c += 2) { chunk(c, sqA, skA, seA, sdA, gwA, rvA); chunk(c + 1, sqB, skB, seB, sdB, gwB, rvB); }
}

__device__ __forceinline__ bool peer_item(int w, int r, int& h, int& ti) { if (r >= 2) return false; const int i = (w >> 3) + 32 * r; h = i & 7; ti = (w & 7) + 8 * (i >> 3); return true; }
__device__ __forceinline__ int f2key(float f) { const int b = __float_as_int(f); return b ^ ((b >> 31) & 0x7fffffff); }
__device__ __forceinline__ float key2f(int k) { return __int_as_float(k ^ ((k >> 31) & 0x7fffffff)); }
__device__ __forceinline__ void ce_desc(int& a, int& b) { const int hi = max(a, b), lo = min(a, b); a = hi; b = lo; }
__device__ __forceinline__ void sort16_desc(int (&a)[16]) {
    ce_desc(a[0], a[13]); ce_desc(a[1], a[12]); ce_desc(a[2], a[15]); ce_desc(a[3], a[14]); ce_desc(a[4], a[8]); ce_desc(a[5], a[6]); ce_desc(a[7], a[11]); ce_desc(a[9], a[10]); ce_desc(a[0], a[5]); ce_desc(a[1], a[7]); ce_desc(a[2], a[9]); ce_desc(a[3], a[4]); ce_desc(a[6], a[13]); ce_desc(a[8], a[14]); ce_desc(a[10], a[15]); ce_desc(a[11], a[12]); ce_desc(a[0], a[1]); ce_desc(a[2], a[3]); ce_desc(a[4], a[5]); ce_desc(a[6], a[8]); ce_desc(a[7], a[9]); ce_desc(a[10], a[11]); ce_desc(a[12], a[13]); ce_desc(a[14], a[15]); ce_desc(a[0], a[2]); ce_desc(a[1], a[3]); ce_desc(a[4], a[10]); ce_desc(a[5], a[11]); ce_desc(a[6], a[7]); ce_desc(a[8], a[9]); ce_desc(a[12], a[14]); ce_desc(a[13], a[15]); ce_desc(a[1], a[2]); ce_desc(a[3], a[12]); ce_desc(a[4], a[6]); ce_desc(a[5], a[7]); ce_desc(a[8], a[10]); ce_desc(a[9], a[11]); ce_desc(a[13], a[14]); ce_desc(a[1], a[4]); ce_desc(a[2], a[6]); ce_desc(a[5], a[8]); ce_desc(a[7], a[10]); ce_desc(a[9], a[13]); ce_desc(a[11], a[14]); ce_desc(a[2], a[4]); ce_desc(a[3], a[6]); ce_desc(a[9], a[12]); ce_desc(a[11], a[13]); ce_desc(a[3], a[5]); ce_desc(a[6], a[8]); ce_desc(a[7], a[9]); ce_desc(a[10], a[12]); ce_desc(a[3], a[4]); ce_desc(a[5], a[6]); ce_desc(a[7], a[8]); ce_desc(a[9], a[10]); ce_desc(a[11], a[12]); ce_desc(a[6], a[7]); ce_desc(a[8], a[9]);
}
__device__ __forceinline__ void merge16_desc(int (&a)[16]) {
#pragma unroll
    for (int j = 8; j > 0; j >>= 1)
#pragma unroll
        for (int i = 0; i < 16; ++i) { const int l = i ^ j; if (l > i) ce_desc(a[i], a[l]); }
}
__device__ __forceinline__ void topmerge16(int (&T)[16], int (&G)[16]) {
#pragma unroll
    for (int i = 0; i < 16; ++i) T[i] = max(T[i], G[15 - i]);
    merge16_desc(T);
}
__device__ __forceinline__ constexpr int cand_a(int s) { int c = 0; for (int a = 0; a < 16; ++a) { const int nb = 16 / (a + 1); if (s < c + nb) return a; c += nb; } return -1; }
__device__ __forceinline__ constexpr int cand_b(int s) { int c = 0; for (int a = 0; a < 16; ++a) { const int nb = 16 / (a + 1); if (s < c + nb) return s - c; c += nb; } return -1; }
__device__ __forceinline__ void ph_peer_topk(const Params& p, int* tl) {
    const int tidx = fresh_tid();
    const bf16_t* ST = (const bf16_t*)(p.ws + WS_Q); int* exi = (int*)(p.ws + WS_EXI);
    const int tid = tidx;
    for (int r = 0; r < 2; ++r) {
        int h, ti; peer_item((int)blockIdx.x, r, h, ti); const int tok = ti * 512 + tid;
        int T1[16], T[16], G[16]; _Float16 raw[16];
        const int tc = tok & 255; const _Float16* src0 = (const _Float16*)ST + (size_t)(h * (NTOK / 256) + (tok >> 8)) * 65536 + ((tc >> 5) & 3) * 8192 + (tc >> 7) * 512 + ((tc >> 3) & 3) * 128 + (tc & 7);
#define SCORE_KOFF(k) ((((k) >> 6) & 1) * 32768 + ((((k) >> 7) * 4 + (((k) >> 4) & 3)) * 1024) + ((k) & 15) * 8)
#pragma unroll
        for (int i = 0; i < 16; ++i) raw[i] = src0[SCORE_KOFF(i)];
#pragma unroll
        for (int gg = 0; gg < 16; ++gg) {
#pragma unroll
            for (int i = 0; i < 16; ++i) G[i] = (f2key((float)raw[i]) & ~0x7f) | ((gg & 7) * 16 + i);
            if (gg < 15) {
#pragma unroll
                for (int i = 0; i < 16; ++i) raw[i] = src0[SCORE_KOFF((gg + 1) * 16 + i)];
            }
            sort16_desc(G);
            if ((gg & 7) == 0) {
#pragma unroll
                for (int i = 0; i < 16; ++i) T[i] = G[i];
            } else topmerge16(T, G);
            if (gg == 7) {
#pragma unroll
                for (int i = 0; i < 16; ++i) T1[i] = T[i];
            }
        }
        __syncthreads();
#pragma unroll
        for (int i = 0; i < 16; ++i) { tl[i * 512 + tid] = T1[i] & 0x7f; tl[(16 + i) * 512 + tid] = T[i] & 0x7f; }
        float v1[16], v2[16];
#pragma unroll
        for (int i = 0; i < 16; ++i) { v1[i] = key2f(T1[i] & ~0x7f); v2[i] = key2f(T[i] & ~0x7f); }
        int R[16];
#pragma unroll
        for (int grp = 0; grp < 4; ++grp) {
#pragma unroll
            for (int i = 0; i < 16; ++i) { constexpr int dummy = 0; (void)dummy; const int sidx = grp * 16 + i; const int a = cand_a(sidx), b = cand_b(sidx);
                G[i] = (a >= 0) ? ((f2key(v1[a >= 0 ? a : 0] + v2[b >= 0 ? b : 0]) & ~0xff) | (a << 4) | b) : (int)0x80000000; }
            sort16_desc(G);
            if (grp == 0) {
#pragma unroll
                for (int i = 0; i < 16; ++i) R[i] = G[i];
            } else topmerge16(R, G);
        }
        float e[16]; float z = 0.f; const float mx = key2f(R[0] & ~0xff);
#pragma unroll
        for (int i = 0; i < 16; ++i) { e[i] = __expf(key2f(R[i] & ~0xff) - mx); z += e[i]; }
        const float rz = 1.0f / z;
        int ids[16];
#pragma unroll
        for (int i = 0; i < 16; ++i) { const int a = (R[i] >> 4) & 15, b = R[i] & 15; ids[i] = tl[a * 512 + tid] * 128 + tl[(16 + b) * 512 + tid]; }
        int4* di = (int4*)(exi + (size_t)tok * 128 + h * 16);
#pragma unroll
        for (int i = 0; i < 16; ++i) ids[i] |= (int)((unsigned)f2bf(e[i] * rz) << 16);
#pragma unroll
        for (int q = 0; q < 4; ++q) di[q] = make_int4(ids[4 * q], ids[4 * q + 1], ids[4 * q + 2], ids[4 * q + 3]);
    }
}
typedef int v4i __attribute__((ext_vector_type(4)));
__device__ __forceinline__ void ph_peer_u(const Params& p, int* sm) {
    const int tidx = fresh_tid();
    const signed char* u8 = (const signed char*)(p.ws + WS_U); const float* su = (const float*)(p.ws + WS_SU); const signed char* x8 = (const signed char*)(p.ws + WS_X8); const float* sx = (const float*)(p.ws + WS_SX);
    const int* exi = (const int*)(p.ws + WS_EXI); int* aout = (int*)(p.ws + WS_AOUT);
    const int wave = __builtin_amdgcn_readfirstlane(tidx >> 6), lane = tidx & 63, j = blockIdx.x & 7, lw = blockIdx.x >> 3, nlw = gridDim.x >> 3, sub = lane & 7, grp = lane >> 3;
    const __amdgpu_buffer_rsrc_t urs = __builtin_amdgcn_make_buffer_rsrc((void*)(u8 + (size_t)j * (2048 * 1024)), (short)0, 2048 * 1024, 0x00020000);
    int2* lst = (int2*)sm + wave * 1024;
    signed char* xs = (signed char*)(sm + 16 * 1024) + wave * (8 * 1152);
    const float2* suv = (const float2*)(p.ws + WS_SUV);
    for (int tb = lw * 8 + wave; tb < NTOK / 8; tb += nlw * 8) {
        const int tok0 = tb * 8;
        int4 ev[4]; int cnt = 0;
#pragma unroll
        for (int q = 0; q < 4; ++q) { ev[q] = *(const int4*)(exi + (size_t)tok0 * 128 + q * 256 + lane * 4);
            cnt += (((ev[q].x >> 11) & 7) == j) + (((ev[q].y >> 11) & 7) == j) + (((ev[q].z >> 11) & 7) == j) + (((ev[q].w >> 11) & 7) == j); }
        v4i xr0 = *(const v4i*)(x8 + (size_t)(tok0 + 0) * 1024 + lane * 16), xr1 = *(const v4i*)(x8 + (size_t)(tok0 + 1) * 1024 + lane * 16), xr2 = *(const v4i*)(x8 + (size_t)(tok0 + 2) * 1024 + lane * 16), xr3 = *(const v4i*)(x8 + (size_t)(tok0 + 3) * 1024 + lane * 16);
        v4i xr4 = *(const v4i*)(x8 + (size_t)(tok0 + 4) * 1024 + lane * 16), xr5 = *(const v4i*)(x8 + (size_t)(tok0 + 5) * 1024 + lane * 16), xr6 = *(const v4i*)(x8 + (size_t)(tok0 + 6) * 1024 + lane * 16), xr7 = *(const v4i*)(x8 + (size_t)(tok0 + 7) * 1024 + lane * 16);
        const float sxv = sx[tok0 + (lane & 7)];
        int incl = cnt;
        incl += __builtin_amdgcn_update_dpp(0, incl, 0x111, 0xf, 0xf, false); incl += __builtin_amdgcn_update_dpp(0, incl, 0x112, 0xf, 0xf, false);
        incl += __builtin_amdgcn_update_dpp(0, incl, 0x114, 0xf, 0xf, false); incl += __builtin_amdgcn_update_dpp(0, incl, 0x118, 0xf, 0xf, false);
        incl += __builtin_amdgcn_update_dpp(0, incl, 0x142, 0xa, 0xf, false);
        incl += __builtin_amdgcn_update_dpp(0, incl, 0x143, 0xc, 0xf, false);
        int pos = incl - cnt; const int total = __builtin_amdgcn_readlane(incl, 63);
        wave_lds_sync();
#pragma unroll
        for (int q = 0; q < 4; ++q) { const int tq_ = (q * 2 + (lane >> 5)) << 21, s0 = (lane & 31) * 4;
            if (((ev[q].x >> 11) & 7) == j) lst[pos++] = make_int2((ev[q].x & 0x3fff) | ((s0 + 0) << 14) | tq_, ev[q].x & (int)0xffff0000);
            if (((ev[q].y >> 11) & 7) == j) lst[pos++] = make_int2((ev[q].y & 0x3fff) | ((s0 + 1) << 14) | tq_, ev[q].y & (int)0xffff0000);
            if (((ev[q].z >> 11) & 7) == j) lst[pos++] = make_int2((ev[q].z & 0x3fff) | ((s0 + 2) << 14) | tq_, ev[q].z & (int)0xffff0000);
            if (((ev[q].w >> 11) & 7) == j) lst[pos++] = make_int2((ev[q].w & 0x3fff) | ((s0 + 3) << 14) | tq_, ev[q].w & (int)0xffff0000); }
        { signed char* xd = xs + lane * 16; *(v4i*)(xd) = xr0; *(v4i*)(xd + 1152) = xr1; *(v4i*)(xd + 2 * 1152) = xr2; *(v4i*)(xd + 3 * 1152) = xr3;
          *(v4i*)(xd + 4 * 1152) = xr4; *(v4i*)(xd + 5 * 1152) = xr5; *(v4i*)(xd + 6 * 1152) = xr6; *(v4i*)(xd + 7 * 1152) = xr7; }
        wave_lds_sync();
#pragma unroll 2
        for (int it = 0; it * 8 < total; ++it) {
            const int i = it * 8 + grp; const bool valid = i < total; const int2 en2 = valid ? lst[i] : make_int2(j << 11, 0); const int ent = en2.x;
            const int e = ent & 0x3fff, ti = (ent >> 21) & 7;
            const int aoff = ((e & 2047) << 10) + sub * 16; const signed char* xp = xs + ti * 1152 + sub * 16;
            const float2 sc2 = suv[e];
            int acc = 0;
#pragma unroll
            for (int st = 0; st < 8; ++st) { const v4i a = __builtin_amdgcn_raw_buffer_load_b128(urs, aoff + st * 128, 0, 0); const int4 x = *(const int4*)(xp + st * 128);
                acc = __builtin_amdgcn_sdot4(a[0], x.x, acc, false); acc = __builtin_amdgcn_sdot4(a[1], x.y, acc, false); acc = __builtin_amdgcn_sdot4(a[2], x.z, acc, false); acc = __builtin_amdgcn_sdot4(a[3], x.w, acc, false); }
            acc += xor_get<1>(acc); acc += xor_get<2>(acc); acc += xor_get<4>(acc);
            const float sxt = __shfl(sxv, ti);
            if (valid && sub == 0) aout[(size_t)(tok0 + ti) * 128 + ((ent >> 14) & 127)] = (int)(((unsigned)f2bf(__int_as_float(en2.y) * gelu_tanh((float)acc * sc2.x * sxt) * sc2.y) << 16) | (unsigned)e);
        }
    }
}
typedef short s16x2 __attribute__((ext_vector_type(2)));
__device__ __forceinline__ int dot2b(unsigned x, unsigned y, unsigned sel, unsigned wpair, int acc) { return __builtin_amdgcn_sdot2(__builtin_bit_cast(s16x2, __builtin_amdgcn_perm(y, x, sel)), __builtin_bit_cast(s16x2, wpair), acc, false); }
__device__ __forceinline__ void ph_peer_v(const Params& p, float* sm, bool dry = false) {
    const int tidx = fresh_tid();
    const unsigned char* v8 = (const unsigned char*)(p.ws + WS_V); const float* sv = (const float*)(p.ws + WS_SV);
    const int* aout = (const int*)(p.ws + WS_AOUT);
    const float* mod = (const float*)(p.ws + WS_MOD); float* ssp = (float*)(p.ws + WS_SSP);
    const int wave = __builtin_amdgcn_readfirstlane(tidx >> 6), lane = tidx & 63, j = blockIdx.x & 7, lw = blockIdx.x >> 3, nlw = gridDim.x >> 3, sub = lane & 7, tk = lane >> 3;
    int* we = (int*)sm + wave * 2048; unsigned* wp = (unsigned*)(we + 1024); float* wsc = (float*)(we + 1536); int* wcorr = we + 1544;
    for (int tb = lw * 8 + wave; tb < NTOK / 8; tb += nlw * 8) {
        const int tok0 = tb * 8;
        wave_lds_sync();
        const int tok = tok0 + tk, col0 = j * 128 + sub * 16; const float* gt = mod + (tok >> 11) * 6144 + 5120 + col0; bf16_t* xo = (bf16_t*)(p.ws + WS_X1B) + (size_t)tok * 1024 + col0;
        const uint4 xw0 = *(const uint4*)(xo), xw1 = *(const uint4*)(xo + 8);
        const float4 gt0 = *(const float4*)(gt), gt1 = *(const float4*)(gt + 4), gt2 = *(const float4*)(gt + 8), gt3 = *(const float4*)(gt + 12);
        { const size_t i0 = (size_t)(tok0 + tk) * 128 + sub * 16;
          int4 e4[4]; float4 w4[4];
#pragma unroll
          for (int q = 0; q < 4; ++q) { const int4 pw_ = *(const int4*)(aout + i0 + 4 * q); e4[q] = make_int4(pw_.x & 0x3fff, pw_.y & 0x3fff, pw_.z & 0x3fff, pw_.w & 0x3fff);
              w4[q] = make_float4(__int_as_float(pw_.x & (int)0xffff0000), __int_as_float(pw_.y & (int)0xffff0000), __int_as_float(pw_.z & (int)0xffff0000), __int_as_float(pw_.w & (int)0xffff0000)); }
          float wmax = 0.f;
#pragma unroll
          for (int q = 0; q < 4; ++q) wmax = fmaxf(fmaxf(wmax, fmaxf(fabsf(w4[q].x), fabsf(w4[q].y))), fmaxf(fabsf(w4[q].z), fabsf(w4[q].w)));
          wmax = fmaxf(wmax, xor_get<1>(wmax)); wmax = fmaxf(wmax, xor_get<2>(wmax)); wmax = fmaxf(wmax, xor_get<4>(wmax));
          const float sc = wmax > 0.f ? 32767.0f / wmax : 0.f;
          int sum = 0;
#pragma unroll
          for (int q = 0; q < 4; ++q) { const int q0 = (int)rintf(w4[q].x * sc), q1 = (int)rintf(w4[q].y * sc), q2 = (int)rintf(w4[q].z * sc), q3 = (int)rintf(w4[q].w * sc);
              sum += (q0 + q1) + (q2 + q3);
              *(int4*)(we + tk * 128 + sub * 16 + 4 * q) = make_int4(e4[q].x << 7, e4[q].y << 7, e4[q].z << 7, e4[q].w << 7);
              *(uint2*)(wp + tk * 64 + sub * 8 + 2 * q) = make_uint2((unsigned)(q0 & 0xffff) | ((unsigned)q1 << 16), (unsigned)(q2 & 0xffff) | ((unsigned)q3 << 16)); }
          sum += xor_get<1>(sum); sum += xor_get<2>(sum); sum += xor_get<4>(sum);
          if (sub == 0) { wsc[tk] = wmax * (1.0f / 32767.0f); wcorr[tk] = 128 * sum; } }
        wave_lds_sync();
        int acc[16];
#pragma unroll
        for (int c = 0; c < 16; ++c) acc[c] = 0;
        const __amdgpu_buffer_rsrc_t vrs = __builtin_amdgcn_make_buffer_rsrc((void*)(v8 + (size_t)j * (16384 * 128)), (short)0, 16384 * 128, 0x00020000);
#pragma unroll 8
        for (int kp = 0; kp < 64; ++kp) {
            const int2 ee = *(const int2*)(we + tk * 128 + 2 * kp); const unsigned wpair = wp[tk * 64 + kp];
            const v4i X = __builtin_amdgcn_raw_buffer_load_b128(vrs, ee.x + sub * 16, 0, 0), Y = __builtin_amdgcn_raw_buffer_load_b128(vrs, ee.y + sub * 16, 0, 0);
            const unsigned xx[4] = {(unsigned)X[0], (unsigned)X[1], (unsigned)X[2], (unsigned)X[3]}, yy[4] = {(unsigned)Y[0], (unsigned)Y[1], (unsigned)Y[2], (unsigned)Y[3]};
#pragma unroll
            for (int d = 0; d < 4; ++d) {
                acc[4 * d + 0] = dot2b(xx[d], yy[d], 0x0c040c00u, wpair, acc[4 * d + 0]); acc[4 * d + 1] = dot2b(xx[d], yy[d], 0x0c050c01u, wpair, acc[4 * d + 1]);
                acc[4 * d + 2] = dot2b(xx[d], yy[d], 0x0c060c02u, wpair, acc[4 * d + 2]); acc[4 * d + 3] = dot2b(xx[d], yy[d], 0x0c070c03u, wpair, acc[4 * d + 3]); }
        }
        const float ws_ = wsc[tk]; const int corr = wcorr[tk];
        float ss = 0.f;
#pragma unroll
        for (int q = 0; q < 2; ++q) { const uint4 xw = q ? xw1 : xw0; const float4 ga = q ? gt2 : gt0, gb = q ? gt3 : gt1;
            const float r0 = __uint_as_float(xw.x << 16) + ga.x * (ws_ * (float)(acc[8 * q] - corr)), r1 = __uint_as_float(xw.x & 0xffff0000u) + ga.y * (ws_ * (float)(acc[8 * q + 1] - corr));
            const float r2 = __uint_as_float(xw.y << 16) + ga.z * (ws_ * (float)(acc[8 * q + 2] - corr)), r3 = __uint_as_float(xw.y & 0xffff0000u) + ga.w * (ws_ * (float)(acc[8 * q + 3] - corr));
            const float r4 = __uint_as_float(xw.z << 16) + gb.x * (ws_ * (float)(acc[8 * q + 4] - corr)), r5 = __uint_as_float(xw.z & 0xffff0000u) + gb.y * (ws_ * (float)(acc[8 * q + 5] - corr));
            const float r6 = __uint_as_float(xw.w << 16) + gb.z * (ws_ * (float)(acc[8 * q + 6] - corr)), r7 = __uint_as_float(xw.w & 0xffff0000u) + gb.w * (ws_ * (float)(acc[8 * q + 7] - corr));
            ss += ((r0 * r0 + r1 * r1) + (r2 * r2 + r3 * r3)) + ((r4 * r4 + r5 * r5) + (r6 * r6 + r7 * r7));
            if (!dry) *(uint4*)(xo + 8 * q) = make_uint4(pack2bf(r0, r1), pack2bf(r2, r3), pack2bf(r4, r5), pack2bf(r6, r7)); }
        ss += xor_get<1>(ss); ss += xor_get<2>(ss); ss += xor_get<4>(ss);
        if (sub == 0) ssp[(size_t)tok * 8 + j] = ss;
    }
}
__device__ __forceinline__ void ph_final_norm(const Params& p) {
    const int tidx = fresh_tid();
    const float* ssp = (const float*)(p.ws + WS_SSP);
    const int wave = tidx >> 6, lane = tidx & 63, wpb = blockDim.x >> 6;
    for (int row = blockIdx.x * wpb + wave; row < NTOK; row += gridDim.x * wpb) {
        float ss = 0.f;
#pragma unroll
        for (int q = 0; q < 8; ++q) ss += ssp[(size_t)row * 8 + q];
        const float rstd = rsqrtf(ss * (1.0f / 1024.0f) + 1e-6f);
        const uint2* xr = (const uint2*)((const bf16_t*)(p.ws + WS_X1B) + (size_t)row * 1024); float4* orow = (float4*)(p.out + (size_t)row * 1024);
#pragma unroll
        for (int i = 0; i < 4; ++i) { const uint2 w = xr[lane + 64 * i]; const float4 g = *(const float4*)(p.g_final + (lane + 64 * i) * 4);
            orow[lane + 64 * i] = make_float4(__uint_as_float(w.x << 16) * rstd * g.x, __uint_as_float(w.x & 0xffff0000u) * rstd * g.y, __uint_as_float(w.y << 16) * rstd * g.z, __uint_as_float(w.y & 0xffff0000u) * rstd * g.w); }
    }
}

#define XB_TMO      128
#define XB_XCNT(j)  (256  + 64 * (j))
#define XB_XSUB(j)  (1280 + 64 * (j))
#define XB_XGEN(j)  (2304 + 64 * (j))
#define XB_TOP      3328
#define XB_TOPGEN   3392
#define XCD_BAR_WORDS 3456
#define XB_SPIN_CAP (1u << 22)
__device__ __forceinline__ unsigned xb_ld(unsigned* p)              { return __hip_atomic_load(p, __ATOMIC_RELAXED, __HIP_MEMORY_SCOPE_AGENT); }
__device__ __forceinline__ unsigned xb_add(unsigned* p, unsigned v) { return __hip_atomic_fetch_add(p, v, __ATOMIC_RELAXED, __HIP_MEMORY_SCOPE_AGENT); }
__device__ __forceinline__ unsigned xb_xcc_id() { return (unsigned)__builtin_amdgcn_s_getreg((3 << 11) | 20) & 0xFu; }
#define XB_SPIN(cond, bar) do { unsigned _sp = 0; while (cond) { __builtin_amdgcn_s_sleep(1); \
    if ((++_sp & 255u) == 0u) { if (xb_ld(&(bar)[XB_TMO])) break; if (_sp > XB_SPIN_CAP) { atomicAdd(&(bar)[XB_TMO], 1u); break; } } } } while (0)
struct XcdBarrier { unsigned* bar; unsigned x; volatile LAS unsigned* st; };
__device__ __forceinline__ XcdBarrier xcd_barrier_post(unsigned* bar, volatile LAS unsigned* st) {
    XcdBarrier b; b.bar = bar; b.x = xb_xcc_id(); b.st = st;
    if (threadIdx.x == 0) (void)xb_add(&bar[XB_XCNT(b.x)], 1u);
    return b;
}
__device__ __forceinline__ void xcd_barrier_complete(unsigned* bar, unsigned x, unsigned& nloc, unsigned& nx) {
    const unsigned G = gridDim.x * gridDim.y * gridDim.z;
    unsigned sum, cnt, mine, sp = 0u;
    for (;;) {
        sum = 0u; cnt = 0u; mine = 0u;
#pragma unroll
        for (unsigned j = 0; j < 16; ++j) { const unsigned c = xb_ld(&bar[XB_XCNT(j)]); sum += c; cnt += (c > 0u) ? 1u : 0u; mine = (j == x) ? c : mine; }
        if (sum == G) break;
        __builtin_amdgcn_s_sleep(1);
        if ((++sp & 255u) == 0u) { if (xb_ld(&bar[XB_TMO])) break; if (sp > XB_SPIN_CAP) { atomicAdd(&bar[XB_TMO], 1u); break; } }
    }
    nloc = mine > 0u ? mine : 1u; nx = cnt > 0u ? cnt : 1u;
}
__device__ __forceinline__ void xcd_barrier(const XcdBarrier& b) {
    asm volatile("s_waitcnt vmcnt(0)" ::: "memory");
    __syncthreads();
    if (threadIdx.x == 0) {
        unsigned* bar = b.bar;
        __builtin_amdgcn_s_waitcnt(0);
        unsigned nloc = b.st[0], nx = b.st[1];
        if (nloc == 0u) { xcd_barrier_complete(bar, b.x, nloc, nx); b.st[0] = nloc; b.st[1] = nx; }
        const unsigned old = xb_add(&bar[XB_XSUB(b.x)], 1u);
        const unsigned gen = old / nloc;
        if (old + 1u == (gen + 1u) * nloc) {
            __builtin_amdgcn_fence(__ATOMIC_RELEASE, "agent");
            asm volatile("s_waitcnt vmcnt(0)" ::: "memory");
            const unsigned og = xb_add(&bar[XB_TOP], 1u);
            const unsigned tg = og / nx;
            if (og + 1u == (tg + 1u) * nx) xb_add(&bar[XB_TOPGEN], 1u);
            else XB_SPIN(xb_ld(&bar[XB_TOPGEN]) == tg, bar);
            __builtin_amdgcn_fence(__ATOMIC_ACQUIRE, "agent");
            xb_add(&bar[XB_XGEN(b.x)], 1u);
            asm volatile("s_waitcnt vmcnt(0)" ::: "memory");
        } else {
            XB_SPIN(xb_ld(&bar[XB_XGEN(b.x)]) == gen, bar);
            __builtin_amdgcn_fence(__ATOMIC_ACQUIRE, "agent");
            asm volatile("s_waitcnt vmcnt(0)" ::: "memory");
        }
    }
    __syncthreads();
}

struct ScoreOrder {
    int w, G;
    __device__ __forceinline__ bool next(int i, pg8::Unit& u) const { int h, ti; if (!peer_item(w, i >> 1, h, ti)) return false; u.pm = h; u.pn = 2 * ti + (i & 1); return true; }
    __device__ __forceinline__ void a_ready(const pg8::Unit&) const {}
    __device__ __forceinline__ void done(const pg8::Unit&) const {}
};
extern __shared__ __attribute__((aligned(16))) unsigned char dyn_smem[];
template <class Epi> __device__ __forceinline__ void run_gemm(const bf16_t* A, const bf16_t* Bt, int M, int N, int K, const Epi& E) {
    pg8::Gemm g{A, Bt, M, N, K, K};
    pg8::StaticOrder S; S.init(g.M, g.N, (int)gridDim.x, (int)blockIdx.x);
    pg8::gemm_phase<Epi, pg8::StaticOrder>((LAS unsigned char*)dyn_smem, g, S, E);
}
__global__ void __launch_bounds__(512, 2) mega_fwd(Params p) {
    float* sm = (float*)dyn_smem; unsigned char* ws = p.ws;
    volatile LAS unsigned* xst = (volatile LAS unsigned*)((LAS unsigned char*)dyn_smem + (144 * 1024 - 16));
    if (threadIdx.x < 4) xst[threadIdx.x] = 0u;
    __syncthreads();
    const XcdBarrier xb = xcd_barrier_post((unsigned*)(ws + WS_BAR), xst);
#define PHASE(k, ...) { __VA_ARGS__; xcd_barrier(xb); } if (PROBE_PHASE == (k)) { __VA_ARGS__; xcd_barrier(xb); }
    PHASE(0, ph_prep(p, sm))
    PHASE(1, ph_rmsnorm_mod<false>(p.x, p.g_mix, (const float*)(ws + WS_MOD), 0, 1024, (bf16_t*)(ws + WS_HBF), nullptr, nullptr))
    PHASE(2, { pg8::EpiProj E{(bf16_t*)(ws + WS_PA), (bf16_t*)(ws + WS_PH), (bf16_t*)(ws + WS_PM), (bf16_t*)(ws + WS_PG), (bf16_t*)((unsigned char*)p.out + DO_KCC), (bf16_t*)((unsigned char*)p.out + DO_VCC),
                     (const float*)(ws + WS_ROPEC), (const float*)(ws + WS_ROPES)};
      run_gemm((const bf16_t*)(ws + WS_HBF), (const bf16_t*)(ws + WS_WIN), NTOK, NPROJ, 1024, E); })
    PHASE(3, {
    if (blockIdx.x >= 64 && blockIdx.x < 96) {
        const int which = (blockIdx.x - 64) >> 4, c = (blockIdx.x - 64) & 15;
        bf16_t* hid = (bf16_t*)((unsigned char*)p.out + DO_HID) + (size_t)which * 4096 * 256;
        pg8::Gemm g{(const bf16_t*)((unsigned char*)p.out + (which ? DO_VCC : DO_KCC)), (const bf16_t*)(ws + (which ? WS_W1TV : WS_W1TK)), 4096, 256, 1024, 1024};
        pg8::StaticOrder S; S.init(g.M, g.N, 16, c);
        pg8::EpiCompress E{hid, (const float*)(ws + WS_C0) + which * 128};
        pg8::gemm_phase<pg8::EpiCompress, pg8::StaticOrder>((LAS unsigned char*)dyn_smem, g, S, E);
        pg8::Unit u; S.next(0, u);
        compress_stage2(hid, (const float*)(ws + WS_C0) + which * 128, which ? p.w_cv2 : p.w_ck2, (bf16_t*)(ws + (which ? WS_VCMP : WS_KCMP)), u.pm, which == 0, sm);
    } else ph_hgrn_pre(p, dyn_smem, blockIdx.x < 64 ? blockIdx.x : blockIdx.x - 32, gridDim.x - 32); })
    PHASE(4, { if (blockIdx.x < 64) ph_hgrn(p, dyn_smem, blockIdx.x); ph_attn(p, dyn_smem, (unsigned*)(ws + WS_BAR + 16384)); })
    PHASE(5, { pg8::EpiBranch E{(const bf16_t*)(ws + WS_PM), (bf16_t*)(ws + WS_Y)}; run_gemm((const bf16_t*)(ws + WS_HBF), (const bf16_t*)(ws + WS_WB), NTOK, 1024, 1024, E); })
    PHASE(6, { pg8::EpiResid E{p.x, (const float*)(ws + WS_MOD), (bf16_t*)(ws + WS_X1B)}; run_gemm((const bf16_t*)(ws + WS_Y), (const bf16_t*)(ws + WS_WOUT), NTOK, 1024, 1024, E); })
    PHASE(7, ph_rmsnorm_mod<true>(ws + WS_X1B, p.g_ffn, (const float*)(ws + WS_MOD), 3072, 4096, (bf16_t*)(ws + WS_HBF), (unsigned*)(ws + WS_X8), (float*)(ws + WS_SX)))
    PHASE(8, { pg8::EpiF16 E{(bf16_t*)(ws + WS_Q), NTOK / 256, 0}; pg8::Gemm g{(const bf16_t*)(ws + WS_WQ), (const bf16_t*)(ws + WS_HBF), 2048, NTOK, 1024, 1024};
               ScoreOrder S{(int)blockIdx.x, (int)gridDim.x}; pg8::gemm_phase<pg8::EpiF16, ScoreOrder>((LAS unsigned char*)dyn_smem, g, S, E);
               __builtin_amdgcn_fence(__ATOMIC_ACQUIRE, "agent"); asm volatile("s_waitcnt vmcnt(0)" ::: "memory"); __syncthreads();
               ph_peer_topk(p, (int*)sm); })
    PHASE(10, ph_peer_u(p, (int*)sm))
#if PROBE_PHASE == 11
    { ph_peer_v(p, sm, true); xcd_barrier(xb); }
#endif
    { ph_peer_v(p, sm); xcd_barrier(xb); }
    ph_final_norm(p);
}

extern "C" void kernel_launch(void* const* d_in, const int* in_sizes, int n_in, void* d_out, int out_size, void* d_ws, size_t ws_size, hipStream_t stream) {
    constexpr size_t kDynLds = 144 * 1024;
    static int grid_blocks = 0;
    if (!grid_blocks) {
        if (ws_size < WS_END) { fprintf(stderr, "kernel_launch: workspace too small (%zu < %zu)\n", ws_size, (size_t)WS_END); grid_blocks = -1; return; }
        int dev = 0, cus = 0, per_cu = 0;
        hipGetDevice(&dev); hipDeviceGetAttribute(&cus, hipDeviceAttributeMultiprocessorCount, dev);
        (void)hipFuncSetAttribute((const void*)mega_fwd, hipFuncAttributeMaxDynamicSharedMemorySize, (int)kDynLds);
        hipOccupancyMaxActiveBlocksPerMultiprocessor(&per_cu, (const void*)mega_fwd, 512, kDynLds);
        if (per_cu < 1) { fprintf(stderr, "kernel_launch: occupancy query says %d blocks/CU\n", per_cu); per_cu = 1; }
        grid_blocks = cus;
    }
    if (grid_blocks < 0) return;
    Params p{};
    p.x = (const float*)d_in[0]; p.c = (const float*)d_in[1]; p.w_ada = (const float*)d_in[2]; p.b_ada = (const float*)d_in[3]; p.g_mix = (const float*)d_in[4]; p.g_ffn = (const float*)d_in[5];
    p.w_in = (const float*)d_in[6]; p.cmp_pos_k = (const float*)d_in[7]; p.cmp_pos_v = (const float*)d_in[8]; p.w_ck1 = (const float*)d_in[9]; p.w_ck2 = (const float*)d_in[10];
    p.w_cv1 = (const float*)d_in[11]; p.w_cv2 = (const float*)d_in[12]; p.lb_logits = (const float*)d_in[13]; p.out_norm = (const float*)d_in[14]; p.w_branch = (const float*)d_in[15];
    p.w_out = (const float*)d_in[16]; p.w_peer_q = (const float*)d_in[17]; p.sub_keys = (const float*)d_in[18]; p.peer_u = (const float*)d_in[19]; p.peer_v = (const float*)d_in[20]; p.g_final = (const float*)d_in[21];
    p.out = (float*)d_out; p.ws = (unsigned char*)d_ws;
    (void)hipMemsetAsync((unsigned char*)d_ws + WS_BAR, 0, 16384 + 256, stream);
    void* args[] = {&p};
    hipError_t e = hipLaunchCooperativeKernel((const void*)mega_fwd, dim3(grid_blocks), dim3(512), args, kDynLds, stream);
    if (e != hipSuccess) fprintf(stderr, "cooperative launch failed: %s (grid %d)\n", hipGetErrorString(e), grid_blocks);
}
```
